# Optimizing an MI355X kernel written in HIP

```python
import jax, jax.numpy as jnp
from jax import lax
import numpy as np

D_MODEL = 1024
BATCH = 8
SEQ = 4096
DEPTH = 1

D_MIX = D_MODEL
SC_WIDTH = D_MIX // 2
LRU_WIDTH = D_MIX - SC_WIDTH
SC_GROUPS = 8
LRU_HEADS = 8
LRU_HEAD_DIM = LRU_WIDTH // LRU_HEADS
SC_CONV_W = 3
LRU_CONV_W = 4
RG_C = 8.0
D_FF = 4 * D_MODEL
N_MOD = 6
EPS = 1e-6
D_IN = 3 * SC_WIDTH + 2 * LRU_WIDTH

kernel_name = "hybrid_shortconv_rglru_adaln_block"


def rmsnorm(x, g):
    xf = x.astype(jnp.float32)
    y = xf * lax.rsqrt(jnp.mean(xf * xf, axis=-1, keepdims=True) + EPS)
    return y.astype(x.dtype) * g


def causal_dwconv(u, w):
    k_w = w.shape[0]
    s = u.shape[1]
    up = jnp.pad(u, ((0, 0), (k_w - 1, 0), (0, 0)))
    out = up[:, 0:s] * w[0]
    for k in range(1, k_w):
        out = out + up[:, k:k + s] * w[k]
    return out


def _lru_combine(left, right):
    a_l, b_l = left
    a_r, b_r = right
    return a_l * a_r, a_r * b_l + b_r


def rg_lru(u, w_a, b_a, w_x, b_x, lam):
    bsz, s, _ = u.shape
    uh = u.reshape(bsz, s, LRU_HEADS, LRU_HEAD_DIM)
    r = jax.nn.sigmoid(jnp.einsum('bshi,hij->bshj', uh, w_a) + b_a)
    i = jax.nn.sigmoid(jnp.einsum('bshi,hij->bshj', uh, w_x) + b_x)
    r32 = r.astype(jnp.float32)
    log_a = -RG_C * r32 * jax.nn.softplus(-lam.astype(jnp.float32).reshape(LRU_HEADS, LRU_HEAD_DIM))
    a = jnp.exp(log_a)
    mult = jnp.sqrt(-jnp.expm1(2.0 * log_a))
    b = mult * (i * uh).astype(jnp.float32)
    _, h = lax.associative_scan(_lru_combine, (a, b), axis=1)
    return h.astype(u.dtype).reshape(bsz, s, LRU_WIDTH)


def setup_inputs(seed: int = 0) -> dict:
    key = jax.random.key(seed)
    ks = jax.random.split(key, 20)
    f32 = jnp.float32
    nrm = lambda k, shape, scale: jax.random.normal(k, shape, f32) * scale
    u = jax.random.uniform(ks[13], (DEPTH, LRU_WIDTH), f32, 0.9, 0.999)
    a0 = u ** (1.0 / RG_C)
    lam = jnp.log(a0) - jnp.log1p(-a0)
    return {
        "x": nrm(ks[0], (BATCH, SEQ, D_MODEL), 1.0),
        "c": nrm(ks[1], (BATCH, D_MODEL), 1.0),
        "w_ada": nrm(ks[2], (DEPTH, D_MODEL, N_MOD * D_MODEL), 0.5 * D_MODEL ** -0.5),
        "b_ada": nrm(ks[3], (DEPTH, N_MOD * D_MODEL), 0.01),
        "g_mix": 1.0 + nrm(ks[4], (DEPTH, D_MODEL), 0.01),
        "w_in": nrm(ks[5], (DEPTH, D_MODEL, D_IN), D_MODEL ** -0.5),
        "conv_w_sc": nrm(ks[6], (DEPTH, SC_CONV_W, SC_WIDTH), SC_CONV_W ** -0.5),
        "conv_w_lru": nrm(ks[7], (DEPTH, LRU_CONV_W, LRU_WIDTH), LRU_CONV_W ** -0.5),
        "conv_b_lru": nrm(ks[8], (DEPTH, LRU_WIDTH), 0.01),
        "w_rg_a": nrm(ks[9], (DEPTH, LRU_HEADS, LRU_HEAD_DIM, LRU_HEAD_DIM), LRU_HEAD_DIM ** -0.5),
        "b_rg_a": nrm(ks[10], (DEPTH, LRU_HEADS, LRU_HEAD_DIM), 0.01),
        "w_rg_x": nrm(ks[11], (DEPTH, LRU_HEADS, LRU_HEAD_DIM, LRU_HEAD_DIM), LRU_HEAD_DIM ** -0.5),
        "b_rg_x": nrm(ks[12], (DEPTH, LRU_HEADS, LRU_HEAD_DIM), 0.01),
        "lru_lambda": lam,
        "w_out": nrm(ks[14], (DEPTH, D_MIX, D_MODEL), D_MIX ** -0.5),
        "g_mlp": 1.0 + nrm(ks[15], (DEPTH, D_MODEL), 0.01),
        "w_up": nrm(ks[16], (DEPTH, D_MODEL, D_FF), D_MODEL ** -0.5),
        "w_down": nrm(ks[17], (DEPTH, D_FF, D_MODEL), D_FF ** -0.5),
        "g_final": 1.0 + nrm(ks[18], (D_MODEL,), 0.01),
    }


def reference(x, c, w_ada, b_ada, g_mix, w_in, conv_w_sc, conv_w_lru, conv_b_lru,
              w_rg_a, b_rg_a, w_rg_x, b_rg_x, lru_lambda, w_out, g_mlp, w_up, w_down,
              g_final):
    c_act = jax.nn.silu(c)
    for l in range(DEPTH):
        mod = c_act @ w_ada[l] + b_ada[l]
        sh_m, sc_m, gt_m, sh_f, sc_f, gt_f = [m[:, None, :] for m in jnp.split(mod, N_MOD, axis=-1)]

        hn = rmsnorm(x, g_mix[l]) * (1.0 + sc_m) + sh_m
        proj = hn @ w_in[l]
        o1 = SC_WIDTH
        o2 = 2 * SC_WIDTH
        o3 = 3 * SC_WIDTH
        o4 = 3 * SC_WIDTH + LRU_WIDTH
        sc_b, sc_c, sc_x = proj[..., :o1], proj[..., o1:o2], proj[..., o2:o3]
        lru_y, lru_x = proj[..., o3:o4], proj[..., o4:]

        y_sc = sc_b * causal_dwconv(sc_c * sc_x, conv_w_sc[l])

        u = causal_dwconv(lru_x, conv_w_lru[l]) + conv_b_lru[l]
        h = rg_lru(u, w_rg_a[l], b_rg_a[l], w_rg_x[l], b_rg_x[l], lru_lambda[l])
        y_lru = jax.nn.gelu(lru_y, approximate=True) * h

        mix = jnp.concatenate([y_sc, y_lru], axis=-1) @ w_out[l]
        x = x + gt_m * mix

        hn = rmsnorm(x, g_mlp[l]) * (1.0 + sc_f) + sh_f
        z = jax.nn.relu(hn @ w_up[l])
        x = x + gt_f * ((z * z) @ w_down[l])
    return rmsnorm(x, g_final)
```

```cpp
#include <hip/hip_runtime.h>
#include <hip/hip_cooperative_groups.h>
#include <cstdio>
#include <cstdint>
namespace cg = cooperative_groups;
namespace pg8 {
#define PG8_LAS __attribute__((address_space(3)))
typedef unsigned short bf16_t;
typedef short bf16x8 __attribute__((ext_vector_type(8)));
typedef float f32x4 __attribute__((ext_vector_type(4)));
typedef unsigned u32x4 __attribute__((ext_vector_type(4)));
constexpr int BM = 256, BK = 64, HALF = 128, HTB = HALF * BK * 2  , STAGE_BYTES = 8 * HTB, NXCD = 8, WGM = 8;

__host__ __device__ __forceinline__ int lds_byte(int r, int c) { const int st = (r >> 4) * 2 + (c >> 5), rr = r & 15, cc = c & 31, ob = rr * 64 + cc * 2; return st * 1024 + (ob ^ (((ob >> 9) & 1) << 5)); }
__host__ __device__ __forceinline__ void stage_rc(int b, int& R, int& C) { const int st = b / 1024, sb = b % 1024, swz = sb ^ (((sb >> 9) & 1) << 5); R = (st >> 1) * 16 + swz / 64; C = (st & 1) * 32 + (swz % 64) / 2; }
__host__ __device__ __forceinline__ int perm32(int rho) { const int n = rho >> 4, i = rho & 15; return 8 * (i >> 2) + 4 * n + (i & 3); }

struct Unit { int pm, pn; };
struct Gemm { const bf16_t* A; const bf16_t* Bt; int M, N, K; };

struct StaticOrder {
    int nM, nN, nwg, G, c;
    __host__ __device__ void init(int M, int N, int G_, int c_) { nM = M / BM; nN = N / BM; nwg = nM * nN; G = G_; c = c_; }
    __host__ __device__ bool next(int i, Unit& u) const {
        const long L = (long)i * G + c; if (L >= nwg) return false;
        int wgid = (int)L; { const int q = nwg / NXCD, r = nwg % NXCD, xcd = wgid % NXCD, off = wgid / NXCD; wgid = (xcd < r ? xcd * (q + 1) : r * (q + 1) + (xcd - r) * q) + off; }
        const int nig = WGM * nN, gid = wgid / nig, fm = gid * WGM, gsz = (nM - fm) < WGM ? (nM - fm) : WGM;
        u.pm = fm + ((wgid % nig) % gsz); u.pn = (wgid % nig) / gsz; return true;
    }
    __device__ __forceinline__ void a_ready(const Unit&) const {}
    __device__ __forceinline__ void done(const Unit&) const {}
};

__device__ __forceinline__ unsigned cvt_pk_bf16(float lo, float hi) { unsigned r; asm volatile("v_cvt_pk_bf16_f32 %0, %1, %2" : "=v"(r) : "v"(lo), "v"(hi)); return r; }
typedef float f32x2 __attribute__((ext_vector_type(2)));
__device__ __forceinline__ f32x2 gelu_pk(f32x2 v) {
    const f32x2 av = __builtin_elementwise_abs(v), d = av * 0.2316418882f + 1.0f;
    f32x2 t; t.x = __builtin_amdgcn_rcpf(d.x); t.y = __builtin_amdgcn_rcpf(d.y);
    f32x2 q = t * 0.5307027145f + (-0.7265760135f); q = q * t + 0.7107068705f; q = q * t + (-0.142248368f); q = q * t + 0.127414796f; q = q * t;
    const f32x2 s = (v * v) * (-0.72134752044f);
    f32x2 e; e.x = __builtin_amdgcn_exp2f(s.x); e.y = __builtin_amdgcn_exp2f(s.y);
    const f32x2 m = v * (q * e), r = v - m;
    f32x2 o; o.x = v.x < 0.f ? m.x : r.x; o.y = v.y < 0.f ? m.y : r.y; return o;
}

template <int ACT  > struct EpiBf16 {
    static constexpr bool PERM = true, AFTER_DRAIN = false; static_assert(ACT == 0 || ACT == 1 || ACT == 2, "EpiBf16: ACT is 0 (none), 1 (gelu_pk) or 2 (squared relu)");
    bf16_t* O; int ldc; const float* bias; int split_cols; size_t split_stride; float scale0;
    __device__ __forceinline__ void operator()(const f32x4 (&acc)[2][2][4][2], const Unit& u, int wr, int wc, int fr, int fq) const {
        const int row0 = u.pm * BM + wr * 64 + fr; int colt = u.pn * BM; bf16_t* base = O;
        float sc = 1.f; if (split_cols) { const int t = colt / split_cols; base += (size_t)t * split_stride; colt -= t * split_cols; if (t == 0) sc = scale0; }
        const int col0 = colt + wc * 32 + 8 * fq, bcol0 = u.pn * BM + wc * 32 + 8 * fq;
        f32x4 bv[2][2];
#pragma unroll
        for (int bj = 0; bj < 2; ++bj)
#pragma unroll
            for (int n = 0; n < 2; ++n) bv[bj][n] = bias ? *(const f32x4*)(bias + bcol0 + bj * HALF + 4 * n) : (f32x4){0.f, 0.f, 0.f, 0.f};
#pragma unroll
        for (int ai = 0; ai < 2; ++ai)
#pragma unroll
            for (int m = 0; m < 4; ++m) { bf16_t* rowp = base + (size_t)(row0 + ai * HALF + m * 16) * ldc + col0;
#pragma unroll
                for (int bj = 0; bj < 2; ++bj) { f32x4 v0 = acc[ai][bj][m][0] + bv[bj][0], v1 = acc[ai][bj][m][1] + bv[bj][1];
                    if (ACT == 1) { f32x2 a = gelu_pk((f32x2){v0[0], v0[1]}), b = gelu_pk((f32x2){v0[2], v0[3]}), c = gelu_pk((f32x2){v1[0], v1[1]}), d = gelu_pk((f32x2){v1[2], v1[3]});
                        v0 = (f32x4){a.x, a.y, b.x, b.y}; v1 = (f32x4){c.x, c.y, d.x, d.y}; }
                    if (ACT == 2) { for (int q_ = 0; q_ < 4; ++q_) { const float a_ = fmaxf(v0[q_], 0.f), b_ = fmaxf(v1[q_], 0.f); v0[q_] = a_ * a_; v1[q_] = b_ * b_; } }
                    v0 = v0 * sc; v1 = v1 * sc; u32x4 w; w.x = cvt_pk_bf16(v0[0], v0[1]); w.y = cvt_pk_bf16(v0[2], v0[3]); w.z = cvt_pk_bf16(v1[0], v1[1]); w.w = cvt_pk_bf16(v1[2], v1[3]);
                    *(u32x4*)(rowp + bj * HALF) = w; } }
    }
};
struct EpiResGate {
    static constexpr bool PERM = false, AFTER_DRAIN = false;
    const float* base; float* out; int ldc; const float* gate; int gstride; int tiles_per_batch;
    __device__ __forceinline__ void operator()(const f32x4 (&acc)[2][2][4][2], const Unit& u, int wr, int wc, int fr, int fq) const {
        const int b = u.pm / tiles_per_batch;
        const int col0 = u.pn * BM + wc * 32 + 4 * fq;
        f32x4 gv[2][2];
#pragma unroll
        for (int bj = 0; bj < 2; ++bj)
#pragma unroll
            for (int n = 0; n < 2; ++n) gv[bj][n] = *(const f32x4*)(gate + (size_t)b * gstride + col0 + bj * HALF + n * 16);
#pragma unroll
        for (int ai = 0; ai < 2; ++ai)
#pragma unroll
            for (int m = 0; m < 4; ++m) { const size_t off = (size_t)(u.pm * BM + ai * HALF + wr * 64 + m * 16 + fr) * ldc + col0;
#pragma unroll
                for (int bj = 0; bj < 2; ++bj)
#pragma unroll
                    for (int n = 0; n < 2; ++n) { const f32x4 bs = *(const f32x4*)(base + off + bj * HALF + n * 16);
                        *(f32x4*)(out + off + bj * HALF + n * 16) = bs + gv[bj][n] * acc[ai][bj][m][n]; }
                if (m & 1) asm volatile("" ::: "memory"); }
    }
};

template <class Epi, class Sched, bool ALIGN_EPI = false, bool SP2 = false>
__device__ __forceinline__ void gemm_phase(PG8_LAS unsigned char* lds, const Gemm g, const Sched& S, const Epi& E) {
    const int tid = threadIdx.x, wid = __builtin_amdgcn_readfirstlane(tid >> 6), lane = tid & 63, wr = wid >> 2, wc = wid & 3, fr = lane & 15, fq = lane >> 4;
    const int K = g.K, nt = K / BK;
    unsigned voffA[2], voffB[2];
#pragma unroll
    for (int i = 0; i < 2; ++i) { int R, C; stage_rc(tid * 16 + i * 8192, R, C); const int Rb = Epi::PERM ? ((R & ~31) + perm32(R & 31)) : R;
        voffA[i] = (unsigned)(R * K + C) * 2u; voffB[i] = (unsigned)(Rb * K + C) * 2u; }
    const size_t kstep = (size_t)(BK * 2);
    const size_t hstep = (size_t)HALF * K * 2;
    const size_t tstep = 2 * hstep;
    const unsigned ldsw = (unsigned)wid * 1024u;
    const int aoff = lds_byte(wr * 64 + fr, fq * 8), boff = lds_byte(wc * 32 + fr, fq * 8);
#define PG8_SA(b, h) (((b) * 2 + (h)) * HTB)
#define PG8_SB(b, h) ((4 + (b) * 2 + (h)) * HTB)
#define PG8_STAGE(bufoff, gbase, voff) do { _Pragma("unroll") for (int _i = 0; _i < 2; ++_i) \
        __builtin_amdgcn_global_load_lds((const unsigned*)((const char*)(gbase) + (voff)[_i]), (PG8_LAS unsigned*)(lds + (bufoff) + ldsw + _i * 8192), 16, 0, 0); } while (0)
#define PG8_LDA(dst, b, h) do { _Pragma("unroll") for (int m = 0; m < 4; ++m) _Pragma("unroll") for (int k = 0; k < 2; ++k) dst[m][k] = *(const PG8_LAS bf16x8*)(lds + PG8_SA(b, h) + aoff + m * 2048 + k * 1024); } while (0)
#define PG8_LDB(dst, b, h) do { _Pragma("unroll") for (int n = 0; n < 2; ++n) _Pragma("unroll") for (int k = 0; k < 2; ++k) dst[n][k] = *(const PG8_LAS bf16x8*)(lds + PG8_SB(b, h) + boff + n * 2048 + k * 1024); } while (0)
#define PG8_MMA(ai, bj, At, Bt) do { __builtin_amdgcn_s_setprio(1); _Pragma("unroll") for (int m = 0; m < 4; ++m) _Pragma("unroll") for (int n = 0; n < 2; ++n) _Pragma("unroll") for (int k = 0; k < 2; ++k) \
        acc[ai][bj][m][n] = __builtin_amdgcn_mfma_f32_16x16x32_bf16(Bt[n][k], At[m][k], acc[ai][bj][m][n], 0, 0, 0); __builtin_amdgcn_s_setprio(0); } while (0)
#define PG8_WAIT_V(n) asm volatile("s_waitcnt vmcnt(" #n ")" ::: "memory")
#define PG8_WAIT_L(n) asm volatile("s_waitcnt lgkmcnt(" #n ")" ::: "memory")
#define PG8_BAR __builtin_amdgcn_s_barrier()
#define PG8_SCHED __builtin_amdgcn_sched_barrier(0)
    Unit cur, nxt; int ui = 0;
    if (!S.next(0, cur)) return;
    f32x4 acc[2][2][4][2];
#pragma unroll
    for (int a = 0; a < 2; ++a)
#pragma unroll
        for (int b = 0; b < 2; ++b)
#pragma unroll
            for (int m = 0; m < 4; ++m)
#pragma unroll
                for (int n = 0; n < 2; ++n) acc[a][b][m][n] = (f32x4){0.f, 0.f, 0.f, 0.f};
    bf16x8 At[4][2], B0[2][2], B1[2][2];
    const char* cA = (const char*)g.A + (size_t)cur.pm * tstep; const char* cB = (const char*)g.Bt + (size_t)cur.pn * tstep;
    S.a_ready(cur);
    if constexpr (SP2) {
        PG8_STAGE(PG8_SB(0, 0), cB, voffB); PG8_STAGE(PG8_SB(0, 1), cB + hstep, voffB); PG8_STAGE(PG8_SA(0, 0), cA, voffA); PG8_STAGE(PG8_SA(0, 1), cA + hstep, voffA);
        if (wr == 1) PG8_BAR;
        PG8_WAIT_V(2); PG8_BAR;
        PG8_STAGE(PG8_SB(1, 0), cB + kstep, voffB); PG8_STAGE(PG8_SA(1, 0), cA + kstep, voffA); PG8_STAGE(PG8_SB(1, 1), cB + hstep + kstep, voffB);
        PG8_WAIT_V(6); PG8_BAR;
    } else {
        PG8_STAGE(PG8_SB(0, 0), cB, voffB); PG8_STAGE(PG8_SA(0, 0), cA, voffA); PG8_STAGE(PG8_SB(0, 1), cB + hstep, voffB); PG8_STAGE(PG8_SA(0, 1), cA + hstep, voffA);
        if (wr == 1) PG8_BAR;
        PG8_WAIT_V(4); PG8_BAR;
        PG8_STAGE(PG8_SB(1, 0), cB + kstep, voffB); PG8_STAGE(PG8_SA(1, 0), cA + kstep, voffA); PG8_STAGE(PG8_SB(1, 1), cB + hstep + kstep, voffB);
        PG8_WAIT_V(6); PG8_BAR;
    }
    for (;;) {
        const bool has_next = S.next(ui + 1, nxt);
        const char* nA = has_next ? (const char*)g.A + (size_t)nxt.pm * tstep : cA; const char* nB = has_next ? (const char*)g.Bt + (size_t)nxt.pn * tstep : cB;
        for (int t = 0; t < nt; t += 2) {
            const bool last = (t == nt - 2);
            const char* a1 = cA + (size_t)(t + 1) * kstep;
            const char* a2 = last ? nA : cA + (size_t)(t + 2) * kstep; const char* b2 = last ? nB : cB + (size_t)(t + 2) * kstep;
            const char* a3 = a2 + kstep; const char* b3 = b2 + kstep;
            if (last && has_next) S.a_ready(nxt);
            if constexpr (SP2) {
            PG8_LDB(B0, 0, 0); PG8_LDB(B1, 0, 1); PG8_SCHED; PG8_LDA(At, 0, 0); PG8_STAGE(PG8_SA(1, 1), a1 + hstep, voffA);
            PG8_WAIT_V(8); PG8_WAIT_L(0); PG8_BAR; PG8_MMA(0, 0, At, B0); PG8_MMA(0, 1, At, B1); PG8_BAR; PG8_SCHED;
            PG8_LDA(At, 0, 1); PG8_STAGE(PG8_SB(0, 0), b2, voffB); PG8_STAGE(PG8_SB(0, 1), b2 + hstep, voffB); PG8_STAGE(PG8_SA(0, 0), a2, voffA);
            PG8_WAIT_V(8); PG8_WAIT_L(0); PG8_BAR; PG8_MMA(1, 0, At, B0); PG8_MMA(1, 1, At, B1); PG8_BAR; PG8_SCHED;
            PG8_LDB(B0, 1, 0); PG8_LDB(B1, 1, 1); PG8_SCHED; PG8_LDA(At, 1, 0); PG8_STAGE(PG8_SA(0, 1), a2 + hstep, voffA);
            PG8_WAIT_V(8); PG8_WAIT_L(0); PG8_BAR; PG8_MMA(0, 0, At, B0); PG8_MMA(0, 1, At, B1); PG8_BAR; PG8_SCHED;
            PG8_LDA(At, 1, 1); PG8_STAGE(PG8_SB(1, 0), b3, voffB); PG8_STAGE(PG8_SB(1, 1), b3 + hstep, voffB); PG8_STAGE(PG8_SA(1, 0), a3, voffA);
            PG8_WAIT_V(8); PG8_WAIT_L(0); PG8_BAR; PG8_MMA(1, 0, At, B0); PG8_MMA(1, 1, At, B1); PG8_BAR; PG8_SCHED;
            } else {
            PG8_LDB(B0, 0, 0); PG8_SCHED; PG8_LDA(At, 0, 0); PG8_STAGE(PG8_SA(1, 1), a1 + hstep, voffA);
            PG8_WAIT_L(8); PG8_BAR; PG8_WAIT_L(0); PG8_MMA(0, 0, At, B0); PG8_BAR; PG8_SCHED;
            PG8_LDB(B1, 0, 1); PG8_STAGE(PG8_SB(0, 0), b2, voffB);
            PG8_BAR; PG8_WAIT_L(0); PG8_MMA(0, 1, At, B1); PG8_BAR;
            PG8_LDA(At, 0, 1); PG8_STAGE(PG8_SA(0, 0), a2, voffA);
            PG8_BAR; PG8_WAIT_L(0); PG8_MMA(1, 0, At, B0); PG8_BAR; PG8_SCHED;
            PG8_STAGE(PG8_SB(0, 1), b2 + hstep, voffB);
            PG8_WAIT_V(6); PG8_BAR; PG8_MMA(1, 1, At, B1); PG8_BAR;
            PG8_LDB(B0, 1, 0); PG8_SCHED; PG8_LDA(At, 1, 0); PG8_STAGE(PG8_SA(0, 1), a2 + hstep, voffA);
            PG8_WAIT_L(8); PG8_BAR; PG8_WAIT_L(0); PG8_MMA(0, 0, At, B0); PG8_BAR; PG8_SCHED;
            PG8_LDB(B1, 1, 1); PG8_STAGE(PG8_SB(1, 0), b3, voffB);
            PG8_BAR; PG8_WAIT_L(0); PG8_MMA(0, 1, At, B1); PG8_BAR;
            PG8_LDA(At, 1, 1); PG8_STAGE(PG8_SA(1, 0), a3, voffA);
            PG8_BAR; PG8_WAIT_L(0); PG8_MMA(1, 0, At, B0); PG8_BAR; PG8_SCHED;
            PG8_STAGE(PG8_SB(1, 1), b3 + hstep, voffB);
            PG8_WAIT_V(6); PG8_BAR; PG8_MMA(1, 1, At, B1); PG8_BAR;
            }
        }
        if constexpr (ALIGN_EPI) { if (wr == 0) PG8_BAR; }
        if constexpr (!Epi::AFTER_DRAIN) { E(acc, cur, wr, wc, fr, fq); S.done(cur); }
        if (!has_next) break;
#pragma unroll
        for (int a = 0; a < 2; ++a)
#pragma unroll
            for (int b = 0; b < 2; ++b)
#pragma unroll
                for (int m = 0; m < 4; ++m)
#pragma unroll
                    for (int n = 0; n < 2; ++n) acc[a][b][m][n] = (f32x4){0.f, 0.f, 0.f, 0.f};
        cur = nxt; cA = nA; cB = nB; ++ui;
        if constexpr (ALIGN_EPI) { if (wr == 1) PG8_BAR; }
    }
    PG8_WAIT_V(0);
    if constexpr (!ALIGN_EPI) { if (wr == 0) PG8_BAR; }
    PG8_BAR;
    if constexpr (Epi::AFTER_DRAIN) { E.fused(acc, cur, wr, wc, fr, fq, lds, wid, lane); S.done(cur); }
#undef PG8_SA
#undef PG8_SB
#undef PG8_STAGE
#undef PG8_LDA
#undef PG8_LDB
#undef PG8_MMA
#undef PG8_WAIT_V
#undef PG8_WAIT_L
#undef PG8_BAR
#undef PG8_SCHED
}
}

constexpr int NWAVES = 8;
constexpr int BATCH = 8, SEQ = 4096, D = 1024, DIN = 2560, FF = 4096, M = BATCH * SEQ;
constexpr int NMOD = 6 * D, SCW = 512, LRW = 512;
constexpr float EPS = 1e-6f;
constexpr int O_SCB = 0, O_SCC = 512, O_SCX = 1024, O_LY = 1536, O_LX = 2048;

constexpr size_t MiB = 1u << 20;
constexpr size_t WS_MOD = 1 * MiB;
constexpr size_t WS_GC = WS_MOD + 256 * 1024;
constexpr size_t WS_F = 2 * MiB;
constexpr size_t WS_WIN = 4 * MiB, WS_WOUT = 10 * MiB, WS_WUP = 12 * MiB, WS_WDN = 20 * MiB;
constexpr size_t WS_XN = 32 * MiB;
constexpr size_t WS_PROJ = 96 * MiB;
constexpr size_t WS_Y = 256 * MiB;
constexpr size_t WS_H = 96 * MiB;
constexpr size_t WS_END = 352 * MiB;

constexpr int LDS_BYTES = 147456;

#define LAS __attribute__((address_space(3)))
typedef unsigned short bf16;
typedef unsigned v4u __attribute__((ext_vector_type(4)));
typedef unsigned v2u __attribute__((ext_vector_type(2)));
typedef float f32x4 __attribute__((ext_vector_type(4)));
typedef float f32x16 __attribute__((ext_vector_type(16)));
typedef short bf16x8 __attribute__((ext_vector_type(8)));

__device__ __forceinline__ unsigned f2bf(float f) { unsigned u = __builtin_bit_cast(unsigned, f); return (u + 0x7fffu + ((u >> 16) & 1u)) >> 16; }
__device__ __forceinline__ unsigned pk2(float lo, float hi) { return f2bf(lo) | (f2bf(hi) << 16); }
__device__ __forceinline__ float bflo(unsigned w) { return __builtin_bit_cast(float, w << 16); }
__device__ __forceinline__ float bfhi(unsigned w) { return __builtin_bit_cast(float, w & 0xffff0000u); }
__device__ __forceinline__ float wave_sum(float v) {
#pragma unroll
    for (int o = 1; o < 64; o <<= 1) v += __shfl_xor(v, o);
    return v;
}
__device__ __forceinline__ float sigmoidf_(float v) { return 1.0f / (1.0f + __expf(-v)); }

__device__ __forceinline__ void p0_transpose_item(const float* W, int K, int N, bf16* WT, LAS float* scr, int item, int lane) {
    const int nblk = N / 32, kb = item / nblk, nb = item % nblk, k0 = 64 * kb, n0 = 32 * nb;
#pragma unroll 8
    for (int i = 0; i < 32; ++i) { const int kk = 2 * i + (lane >> 5); scr[kk * 33 + (lane & 31)] = W[(size_t)(k0 + kk) * N + n0 + (lane & 31)]; }
    asm volatile("s_waitcnt lgkmcnt(0)" ::: "memory");
    const int c = lane & 7;
#pragma unroll
    for (int j = 0; j < 4; ++j) { const int n = (lane >> 3) + 8 * j; const LAS float* s = scr + (8 * c) * 33 + n;
        v4u o; o.x = pk2(s[0 * 33], s[1 * 33]); o.y = pk2(s[2 * 33], s[3 * 33]); o.z = pk2(s[4 * 33], s[5 * 33]); o.w = pk2(s[6 * 33], s[7 * 33]);
        *(v4u*)(WT + (size_t)(n0 + n) * K + k0 + 8 * c) = o; }
    asm volatile("s_waitcnt lgkmcnt(0)" ::: "memory");
}

struct Args { const float* in[19]; float* out; unsigned char* ws; };

__device__ __forceinline__ void norm_mod_phase(const float* X, bf16* XN, const float* g, const float* sc, const float* sh, int gw, int NGW, int lane) {
    for (int gi = gw; gi < M / 16; gi += NGW) {
        const int b = gi >> 8;
        f32x4 S[4], Hh[4];
#pragma unroll
        for (int j = 0; j < 4; ++j) { const int col = 4 * lane + 256 * j; const f32x4 gv = *(const f32x4*)(g + col), sv = *(const f32x4*)(sc + (size_t)b * NMOD + col);
            S[j] = gv * (sv + 1.0f); Hh[j] = *(const f32x4*)(sh + (size_t)b * NMOD + col); }
#pragma unroll 4
        for (int r = 0; r < 16; ++r) {
            const size_t row = (size_t)gi * 16 + r;
            const f32x4* xr = (const f32x4*)(X + row * D) + lane;
            f32x4 v[4]; float s = 0.f;
#pragma unroll
            for (int j = 0; j < 4; ++j) { v[j] = xr[64 * j]; s += (v[j].x * v[j].x + v[j].y * v[j].y) + (v[j].z * v[j].z + v[j].w * v[j].w); }
            const float rstd = 1.0f / sqrtf(wave_sum(s) * (1.0f / D) + EPS);
            v2u* o8 = (v2u*)(XN + row * D) + lane;
#pragma unroll
            for (int j = 0; j < 4; ++j) { const f32x4 o = v[j] * rstd * S[j] + Hh[j]; v2u w; w.x = pk2(o.x, o.y); w.y = pk2(o.z, o.w); o8[64 * j] = w; }
        }
    }
}
__device__ __forceinline__ void final_norm_phase(float* X, const float* g, int gw, int NGW, int lane) {
    f32x4 S[4];
#pragma unroll
    for (int j = 0; j < 4; ++j) S[j] = *(const f32x4*)(g + 4 * lane + 256 * j);
    for (int gi = gw; gi < M / 16; gi += NGW) {
#pragma unroll 4
        for (int r = 0; r < 16; ++r) {
            const size_t row = (size_t)gi * 16 + r;
            f32x4* xr = (f32x4*)(X + row * D) + lane;
            f32x4 v[4]; float s = 0.f;
#pragma unroll
            for (int j = 0; j < 4; ++j) { v[j] = xr[64 * j]; s += (v[j].x * v[j].x + v[j].y * v[j].y) + (v[j].z * v[j].z + v[j].w * v[j].w); }
            const float rstd = 1.0f / sqrtf(wave_sum(s) * (1.0f / D) + EPS);
#pragma unroll
            for (int j = 0; j < 4; ++j) xr[64 * j] = v[j] * rstd * S[j];
        }
    }
}

__device__ __forceinline__ void unpack8(const v4u w, float (&f)[8]) { f[0] = bflo(w.x); f[1] = bfhi(w.x); f[2] = bflo(w.y); f[3] = bfhi(w.y); f[4] = bflo(w.z); f[5] = bfhi(w.z); f[6] = bflo(w.w); f[7] = bfhi(w.w); }
__device__ __forceinline__ void sc_phase(const bf16* PROJ, bf16* Y, const float* wsc, int gw, int NGW, int lane) {
    float w0[8], w1[8], w2[8];
#pragma unroll
    for (int e = 0; e < 8; ++e) { w0[e] = wsc[0 * SCW + 8 * lane + e]; w1[e] = wsc[1 * SCW + 8 * lane + e]; w2[e] = wsc[2 * SCW + 8 * lane + e]; }
    for (int wi = gw; wi < M / 16; wi += NGW) {
        const size_t row0 = (size_t)wi * 16;
        float p1[8], p2[8];
        if ((row0 & (SEQ - 1)) == 0) {
#pragma unroll
            for (int e = 0; e < 8; ++e) { p1[e] = 0.f; p2[e] = 0.f; }
        } else {
            float c[8], x[8];
            unpack8(*(const v4u*)(PROJ + (row0 - 2) * DIN + O_SCC + 8 * lane), c); unpack8(*(const v4u*)(PROJ + (row0 - 2) * DIN + O_SCX + 8 * lane), x);
#pragma unroll
            for (int e = 0; e < 8; ++e) p2[e] = c[e] * x[e];
            unpack8(*(const v4u*)(PROJ + (row0 - 1) * DIN + O_SCC + 8 * lane), c); unpack8(*(const v4u*)(PROJ + (row0 - 1) * DIN + O_SCX + 8 * lane), x);
#pragma unroll
            for (int e = 0; e < 8; ++e) p1[e] = c[e] * x[e];
        }
#pragma unroll 4
        for (int r = 0; r < 16; ++r) {
            const size_t row = row0 + r;
            float bq[8], c[8], x[8], y[8];
            unpack8(*(const v4u*)(PROJ + row * DIN + O_SCB + 8 * lane), bq);
            unpack8(*(const v4u*)(PROJ + row * DIN + O_SCC + 8 * lane), c);
            unpack8(*(const v4u*)(PROJ + row * DIN + O_SCX + 8 * lane), x);
#pragma unroll
            for (int e = 0; e < 8; ++e) { const float p0 = c[e] * x[e]; y[e] = bq[e] * (w0[e] * p2[e] + w1[e] * p1[e] + w2[e] * p0); p2[e] = p1[e]; p1[e] = p0; }
            v4u o; o.x = pk2(y[0], y[1]); o.y = pk2(y[2], y[3]); o.z = pk2(y[4], y[5]); o.w = pk2(y[6], y[7]);
            *(v4u*)(Y + row * D + 8 * lane) = o;
        }
    }
}

template <int CTRL, int RMASK> __device__ __forceinline__ float dpp_old(float oldv, float v) {
    return __builtin_bit_cast(float, __builtin_amdgcn_update_dpp(__builtin_bit_cast(int, oldv), __builtin_bit_cast(int, v), CTRL, RMASK, 0xf, false));
}
#define SCAN_STEP(CTRL, RMASK) do { _Pragma("unroll") for (int e = 0; e < 8; ++e) { const float aL = dpp_old<CTRL, RMASK>(1.0f, a[e]), bL = dpp_old<CTRL, RMASK>(0.0f, bb[e]); bb[e] = a[e] * bL + bb[e]; a[e] = aL * a[e]; } } while (0)
__device__ __forceinline__ float gelu_tanh(float v) {
    const float z = 0.7978845608028654f * (v + 0.044715f * v * v * v);
    const float t = 1.0f - 2.0f / (__expf(2.0f * z) + 1.0f);
    return 0.5f * v * (1.0f + t);
}
__device__ __forceinline__ void lru_phase(LAS unsigned char* lds, const bf16* PROJ, bf16* Y, const bf16* Fw, const float* GC, const float* wl_g, const float* cb_g, const float* lam_g, int G, int tid, int wave, int lane) {
    LAS bf16x8* Fl = (LAS bf16x8*)lds;
    LAS float* carry = (LAS float*)(lds + 16384);
    volatile LAS int* flag = (volatile LAS int*)(lds + 16384 + 129 * 64);
    const int n = lane & 31, h = lane >> 5;
    for (int unit = blockIdx.x; unit < 256; unit += G) {
        const int b = unit >> 5, head = (unit >> 2) & 7, q = unit & 3;
        __syncthreads();
        { const v4u* Fg = (const v4u*)Fw + (size_t)(head * 4 + q) * 1024; LAS v4u* Fd = (LAS v4u*)lds;
          for (int i = tid; i < 1024; i += NWAVES * 64) Fd[i] = Fg[i]; }
        for (int i = tid; i < 129; i += NWAVES * 64) flag[i] = (i == 0) ? 1 : 0;
        if (tid < 16) carry[tid] = 0.f;
        __syncthreads();
        const int chb = 64 * head + 16 * q + 8 * h;
        float ca[8], cx[8], sp8[8], cb[8], wl[4][8];
#pragma unroll
        for (int e = 0; e < 8; ++e) { const int ch = chb + e;
            ca[e] = GC[(head * 2 + 0) * 64 + 16 * q + 8 * h + e]; cx[e] = GC[(head * 2 + 1) * 64 + 16 * q + 8 * h + e];
            sp8[e] = -8.0f * log1pf(expf(-lam_g[ch])); cb[e] = cb_g[ch];
#pragma unroll
            for (int j = 0; j < 4; ++j) wl[j][e] = wl_g[j * LRW + ch]; }
        const bf16* P = PROJ + (size_t)b * SEQ * DIN;
        for (int g = wave; g < SEQ / 32; g += NWAVES) {
            const int t = 32 * g + n;
            bf16x8 fr[4][4]; v4u xo[4];
#pragma unroll
            for (int j = 0; j < 4; ++j) { const int tt = t - 3 + j; const bool ok = tt >= 0; const bf16* rp = P + (size_t)(ok ? tt : 0) * DIN + O_LX;
#pragma unroll
                for (int cs = 0; cs < 4; ++cs) { bf16x8 v = *(const bf16x8*)(rp + 64 * head + 16 * cs + 8 * h); if (!ok) v = (bf16x8){0, 0, 0, 0, 0, 0, 0, 0}; fr[j][cs] = v; }
                v4u xv = *(const v4u*)(rp + chb); if (!ok) xv = (v4u){0u, 0u, 0u, 0u}; xo[j] = xv; }
            const v4u gtv = *(const v4u*)(P + (size_t)t * DIN + O_LY + chb);
            f32x16 acc;
#pragma unroll
            for (int i = 0; i < 16; ++i) acc[i] = 0.f;
#pragma unroll
            for (int j = 0; j < 4; ++j)
#pragma unroll
                for (int cs = 0; cs < 4; ++cs) acc = __builtin_amdgcn_mfma_f32_32x32x16_bf16(Fl[(j * 4 + cs) * 64 + lane], fr[j][cs], acc, 0, 0, 0);
            float a[8], bb[8];
            { float x0[8], x1[8], x2[8], x3[8]; unpack8(xo[0], x0); unpack8(xo[1], x1); unpack8(xo[2], x2); unpack8(xo[3], x3);
#pragma unroll
              for (int e = 0; e < 8; ++e) {
                const float u = cb[e] + wl[0][e] * x0[e] + wl[1][e] * x1[e] + wl[2][e] * x2[e] + wl[3][e] * x3[e];
                const float r = sigmoidf_(acc[e] + ca[e]), ig = sigmoidf_(acc[8 + e] + cx[e]);
                const float la = sp8[e] * r;
                a[e] = __expf(la);
                const float x2l = 2.0f * la;
                const float om = (x2l > -0.03f) ? -(x2l * (1.0f + x2l * (0.5f + x2l * (0.16666667f + x2l * 0.041666668f)))) : (1.0f - __expf(x2l));
                bb[e] = sqrtf(om) * ig * u; } }
            SCAN_STEP(0x111, 0xf); SCAN_STEP(0x112, 0xf); SCAN_STEP(0x114, 0xf); SCAN_STEP(0x118, 0xf); SCAN_STEP(0x142, 0xa);
            while (flag[g] == 0) __builtin_amdgcn_s_sleep(1);
            asm volatile("" ::: "memory");
            float hh[8];
            { const f32x4 c0 = *(const LAS f32x4*)(carry + g * 16 + 8 * h), c1 = *(const LAS f32x4*)(carry + g * 16 + 8 * h + 4);
              const float hin[8] = {c0.x, c0.y, c0.z, c0.w, c1.x, c1.y, c1.z, c1.w};
#pragma unroll
              for (int e = 0; e < 8; ++e) hh[e] = bb[e] + a[e] * hin[e]; }
            if (n == 31) { *(LAS f32x4*)(carry + (g + 1) * 16 + 8 * h) = (f32x4){hh[0], hh[1], hh[2], hh[3]}; *(LAS f32x4*)(carry + (g + 1) * 16 + 8 * h + 4) = (f32x4){hh[4], hh[5], hh[6], hh[7]}; }
            asm volatile("s_waitcnt lgkmcnt(0)" ::: "memory");
            if (lane == 0) flag[g + 1] = 1;
            float gt[8]; unpack8(gtv, gt);
            float y[8];
#pragma unroll
            for (int e = 0; e < 8; ++e) y[e] = gelu_tanh(gt[e]) * hh[e];
            v4u o; o.x = pk2(y[0], y[1]); o.y = pk2(y[2], y[3]); o.z = pk2(y[4], y[5]); o.w = pk2(y[6], y[7]);
            *(v4u*)(Y + ((size_t)b * SEQ + t) * D + SCW + chb) = o;
        }
    }
    __syncthreads();
}

__global__ void __launch_bounds__(NWAVES * 64, 2) fwd_megakernel(Args args) {
    extern __shared__ __attribute__((aligned(16))) unsigned char lds_raw[];
    LAS unsigned char* lds = (LAS unsigned char*)lds_raw;
    cg::grid_group grid = cg::this_grid();
    const int tid = threadIdx.x, lane = tid & 63, wave = __builtin_amdgcn_readfirstlane(tid >> 6);
    const int G = gridDim.x, bx = blockIdx.x;
    const int gw = bx * NWAVES + wave, NGW = G * NWAVES;
    unsigned char* ws = args.ws;
    const float* x = args.in[0]; const float* c_in = args.in[1]; const float* w_ada = args.in[2]; const float* b_ada = args.in[3]; const float* g_mix = args.in[4];
    const float* w_in = args.in[5]; const float* conv_w_sc = args.in[6]; const float* conv_w_lru = args.in[7]; const float* conv_b_lru = args.in[8];
    const float* w_rg_a = args.in[9]; const float* b_rg_a = args.in[10]; const float* w_rg_x = args.in[11]; const float* b_rg_x = args.in[12]; const float* lam = args.in[13];
    const float* w_out = args.in[14]; const float* g_mlp = args.in[15]; const float* w_up = args.in[16]; const float* w_down = args.in[17]; const float* g_final = args.in[18];
    float* out = args.out;
    float* MOD = (float*)(ws + WS_MOD); float* GC = (float*)(ws + WS_GC); bf16* Fw = (bf16*)(ws + WS_F);
    bf16* Win_t = (bf16*)(ws + WS_WIN); bf16* Wout_t = (bf16*)(ws + WS_WOUT); bf16* Wup_t = (bf16*)(ws + WS_WUP); bf16* Wdn_t = (bf16*)(ws + WS_WDN);
    bf16* XN = (bf16*)(ws + WS_XN); bf16* PROJ = (bf16*)(ws + WS_PROJ); bf16* Y = (bf16*)(ws + WS_Y); bf16* HB = (bf16*)(ws + WS_H);

    {
        LAS float* sl = (LAS float*)lds; LAS float* part = sl + 8192;
        for (int item = bx; item < NMOD / 64; item += G) {
            for (int i = tid; i < BATCH * D; i += NWAVES * 64) { const float cv = c_in[i]; sl[i] = cv / (1.0f + __expf(-cv)); }
            __syncthreads();
            const int nn = item * 64 + lane, k0 = wave * 128;
            float acc[8];
#pragma unroll
            for (int b = 0; b < 8; ++b) acc[b] = 0.f;
#pragma unroll 4
            for (int k = k0; k < k0 + 128; ++k) { const float wv = w_ada[(size_t)k * NMOD + nn];
#pragma unroll
                for (int b = 0; b < 8; ++b) acc[b] += sl[b * D + k] * wv; }
#pragma unroll
            for (int b = 0; b < 8; ++b) part[(wave * 8 + b) * 64 + lane] = acc[b];
            __syncthreads();
            float s = b_ada[nn];
#pragma unroll
            for (int w2 = 0; w2 < 8; ++w2) s += part[(w2 * 8 + wave) * 64 + lane];
            MOD[(size_t)wave * NMOD + nn] = s;
            __syncthreads();
        }
        LAS float* scr = (LAS float*)(lds + wave * 16384);
        constexpr int I_IN = (D / 64) * (DIN / 32), I_OUT = (D / 64) * (D / 32), I_UP = (D / 64) * (FF / 32), I_DN = (FF / 64) * (D / 32);
        constexpr int NITEMS = I_IN + I_OUT + I_UP + I_DN;
        for (int it = gw; it < NITEMS; it += NGW) {
            int r = it;
            if (r < I_IN) { p0_transpose_item(w_in, D, DIN, Win_t, scr, r, lane); continue; } r -= I_IN;
            if (r < I_OUT) { p0_transpose_item(w_out, D, D, Wout_t, scr, r, lane); continue; } r -= I_OUT;
            if (r < I_UP) { p0_transpose_item(w_up, D, FF, Wup_t, scr, r, lane); continue; } r -= I_UP;
            p0_transpose_item(w_down, FF, D, Wdn_t, scr, r, lane);
        }
        for (int i = bx * (NWAVES * 64) + tid; i < 32 * 8192; i += G * NWAVES * 64) {
            const int unit = i >> 13, ks = (i >> 9) & 15, ln = (i >> 3) & 63, jj = i & 7;
            const int head = unit >> 2, q = unit & 3, m = ln & 31, k = 16 * ks + 8 * (ln >> 5) + jj, tap = k >> 6, c = k & 63;
            const int mm = m & 15, cho = 16 * q + 8 * ((mm >> 2) & 1) + 4 * (mm >> 3) + (mm & 3);
            const float* Wg = (m >> 4) ? w_rg_x : w_rg_a;
            const float v = conv_w_lru[tap * LRW + 64 * head + c] * Wg[((size_t)head * 64 + c) * 64 + cho];
            Fw[i] = (bf16)f2bf(v);
        }
        for (int i = bx * (NWAVES * 64) + tid; i < 8 * 2 * 64; i += G * NWAVES * 64) {
            const int head = i >> 7, gate = (i >> 6) & 1, o = i & 63;
            const float* Wg = gate ? w_rg_x : w_rg_a; const float* bg = gate ? b_rg_x : b_rg_a;
            float s = bg[head * 64 + o];
            for (int c = 0; c < 64; ++c) s += conv_b_lru[64 * head + c] * Wg[((size_t)head * 64 + c) * 64 + o];
            GC[i] = s;
        }
    }
    grid.sync();
    norm_mod_phase(x, XN, g_mix, MOD + 1 * D, MOD + 0 * D, gw, NGW, lane);
    grid.sync();
    {
        pg8::Gemm g{XN, Win_t, M, DIN, D}; pg8::StaticOrder S; S.init(M, DIN, G, bx);
        pg8::EpiBf16<0> E{PROJ, DIN, nullptr, 0, 0, 1.f};
        pg8::gemm_phase<pg8::EpiBf16<0>, pg8::StaticOrder, true, true>(lds, g, S, E);
    }
    grid.sync();
    sc_phase(PROJ, Y, conv_w_sc, gw, NGW, lane);
    lru_phase(lds, PROJ, Y, Fw, GC, conv_w_lru, conv_b_lru, lam, G, tid, wave, lane);
    grid.sync();
    {
        pg8::Gemm g{Y, Wout_t, M, D, D}; pg8::StaticOrder S; S.init(M, D, G, bx);
        pg8::EpiResGate E{x, out, D, MOD + 2 * D, NMOD, SEQ / 256};
        pg8::gemm_phase<pg8::EpiResGate, pg8::StaticOrder, true, true>(lds, g, S, E);
    }
    grid.sync();
    norm_mod_phase(out, XN, g_mlp, MOD + 4 * D, MOD + 3 * D, gw, NGW, lane);
    grid.sync();
    {
        pg8::Gemm g{XN, Wup_t, M, FF, D}; pg8::StaticOrder S; S.init(M, FF, G, bx);
        pg8::EpiBf16<2> E{HB, FF, nullptr, 0, 0, 1.f};
        pg8::gemm_phase<pg8::EpiBf16<2>, pg8::StaticOrder, true, true>(lds, g, S, E);
    }
    grid.sync();
    {
        pg8::Gemm g{HB, Wdn_t, M, D, FF}; pg8::StaticOrder S; S.init(M, D, G, bx);
        pg8::EpiResGate E{out, out, D, MOD + 5 * D, NMOD, SEQ / 256};
        pg8::gemm_phase<pg8::EpiResGate, pg8::StaticOrder, true, true>(lds, g, S, E);
    }
    grid.sync();
    final_norm_phase(out, g_final, gw, NGW, lane);
}

extern "C" void kernel_launch(void* const* d_in, const int* in_sizes, int n_in, void* d_out, int out_size, void* d_ws, size_t ws_size, hipStream_t stream) {
    static int grid = 0;
    if (grid == 0) {
        if (n_in != 19 || in_sizes[0] != M * D || out_size != M * D || ws_size < WS_END) { fprintf(stderr, "kernel_launch: unexpected shapes (n_in %d, in0 %d, out %d, ws %zu); nothing launched\n", n_in, n_in > 0 ? in_sizes[0] : -1, out_size, ws_size); grid = -1; return; }
        int dev = 0, cus = 0, per_cu = 0;
        if (hipGetDevice(&dev) != hipSuccess || hipDeviceGetAttribute(&cus, hipDeviceAttributeMultiprocessorCount, dev) != hipSuccess) { grid = -1; return; }
        if (hipFuncSetAttribute((const void*)fwd_megakernel, hipFuncAttributeMaxDynamicSharedMemorySize, LDS_BYTES) != hipSuccess) { fprintf(stderr, "kernel_launch: hipFuncSetAttribute failed\n"); grid = -1; return; }
        if (hipOccupancyMaxActiveBlocksPerMultiprocessor(&per_cu, (const void*)fwd_megakernel, NWAVES * 64, LDS_BYTES) != hipSuccess || per_cu < 1) { fprintf(stderr, "kernel_launch: occupancy query gave %d\n", per_cu); per_cu = 1; }
        (void)hipGetLastError();
        grid = cus * per_cu;
    }
    if (grid < 0) return;
    Args a{};
    for (int i = 0; i < 19; ++i) a.in[i] = (const float*)d_in[i];
    a.out = (float*)d_out; a.ws = (unsigned char*)d_ws;
    void* kargs[] = {&a};
    hipError_t e = hipLaunchCooperativeKernel((const void*)fwd_megakernel, dim3(grid), dim3(NWAVES * 64), kargs, LDS_BYTES, stream);
    if (e != hipSuccess) fprintf(stderr, "kernel_launch: cooperative launch failed: %s (grid %d)\n", hipGetErrorString(e), grid);
}
```

```cpp
#include <hip/hip_runtime.h>
#include <hip/hip_cooperative_groups.h>
#include <cstdio>
#include <cstdint>
namespace cg = cooperative_groups;
namespace pg8 {
#define PG8_LAS __attribute__((address_space(3)))
typedef unsigned short bf16_t;
typedef short bf16x8 __attribute__((ext_vector_type(8)));
typedef float f32x4 __attribute__((ext_vector_type(4)));
typedef unsigned u32x4 __attribute__((ext_vector_type(4)));
constexpr int BM = 256, BK = 64, HALF = 128, HTB = HALF * BK * 2  , STAGE_BYTES = 8 * HTB, NXCD = 8, WGM = 8;

__host__ __device__ __forceinline__ int lds_byte(int r, int c) { const int st = (r >> 4) * 2 + (c >> 5), rr = r & 15, cc = c & 31, ob = rr * 64 + cc * 2; return st * 1024 + (ob ^ (((ob >> 9) & 1) << 5)); }
__host__ __device__ __forceinline__ void stage_rc(int b, int& R, int& C) { const int st = b / 1024, sb = b % 1024, swz = sb ^ (((sb >> 9) & 1) << 5); R = (st >> 1) * 16 + swz / 64; C = (st & 1) * 32 + (swz % 64) / 2; }
__host__ __device__ __forceinline__ int perm32(int rho) { const int n = rho >> 4, i = rho & 15; return 8 * (i >> 2) + 4 * n + (i & 3); }

struct Unit { int pm, pn; };
struct Gemm { const bf16_t* A; const bf16_t* Bt; int M, N, K; };

struct StaticOrder {
    int nM, nN, nwg, G, c;
    __host__ __device__ void init(int M, int N, int G_, int c_) { nM = M / BM; nN = N / BM; nwg = nM * nN; G = G_; c = c_; }
    __host__ __device__ bool next(int i, Unit& u) const {
        const long L = (long)i * G + c; if (L >= nwg) return false;
        int wgid = (int)L; { const int q = nwg / NXCD, r = nwg % NXCD, xcd = wgid % NXCD, off = wgid / NXCD; wgid = (xcd < r ? xcd * (q + 1) : r * (q + 1) + (xcd - r) * q) + off; }
        const int nig = WGM * nN, gid = wgid / nig, fm = gid * WGM, gsz = (nM - fm) < WGM ? (nM - fm) : WGM;
        u.pm = fm + ((wgid % nig) % gsz); u.pn = (wgid % nig) / gsz; return true;
    }
    __device__ __forceinline__ void a_ready(const Unit&) const {}
    __device__ __forceinline__ void done(const Unit&) const {}
};

__device__ __forceinline__ unsigned cvt_pk_bf16(float lo, float hi) { unsigned r; asm volatile("v_cvt_pk_bf16_f32 %0, %1, %2" : "=v"(r) : "v"(lo), "v"(hi)); return r; }
typedef float f32x2 __attribute__((ext_vector_type(2)));
__device__ __forceinline__ f32x2 gelu_pk(f32x2 v) {
    const f32x2 av = __builtin_elementwise_abs(v), d = av * 0.2316418882f + 1.0f;
    f32x2 t; t.x = __builtin_amdgcn_rcpf(d.x); t.y = __builtin_amdgcn_rcpf(d.y);
    f32x2 q = t * 0.5307027145f + (-0.7265760135f); q = q * t + 0.7107068705f; q = q * t + (-0.142248368f); q = q * t + 0.127414796f; q = q * t;
    const f32x2 s = (v * v) * (-0.72134752044f);
    f32x2 e; e.x = __builtin_amdgcn_exp2f(s.x); e.y = __builtin_amdgcn_exp2f(s.y);
    const f32x2 m = v * (q * e), r = v - m;
    f32x2 o; o.x = v.x < 0.f ? m.x : r.x; o.y = v.y < 0.f ? m.y : r.y; return o;
}

template <int ACT  > struct EpiBf16 {
    static constexpr bool PERM = true, AFTER_DRAIN = false; static_assert(ACT == 0 || ACT == 1 || ACT == 2, "EpiBf16: ACT is 0 (none), 1 (gelu_pk) or 2 (squared relu)");
    bf16_t* O; int ldc; const float* bias; int split_cols; size_t split_stride; float scale0;
    __device__ __forceinline__ void operator()(const f32x4 (&acc)[2][2][4][2], const Unit& u, int wr, int wc, int fr, int fq) const {
        const int row0 = u.pm * BM + wr * 64 + fr; int colt = u.pn * BM; bf16_t* base = O;
        float sc = 1.f; if (split_cols) { const int t = colt / split_cols; base += (size_t)t * split_stride; colt -= t * split_cols; if (t == 0) sc = scale0; }
        const int col0 = colt + wc * 32 + 8 * fq, bcol0 = u.pn * BM + wc * 32 + 8 * fq;
        f32x4 bv[2][2];
#pragma unroll
        for (int bj = 0; bj < 2; ++bj)
#pragma unroll
            for (int n = 0; n < 2; ++n) bv[bj][n] = bias ? *(const f32x4*)(bias + bcol0 + bj * HALF + 4 * n) : (f32x4){0.f, 0.f, 0.f, 0.f};
#pragma unroll
        for (int ai = 0; ai < 2; ++ai)
#pragma unroll
            for (int m = 0; m < 4; ++m) { bf16_t* rowp = base + (size_t)(row0 + ai * HALF + m * 16) * ldc + col0;
#pragma unroll
                for (int bj = 0; bj < 2; ++bj) { f32x4 v0 = acc[ai][bj][m][0] + bv[bj][0], v1 = acc[ai][bj][m][1] + bv[bj][1];
                    if (ACT == 1) { f32x2 a = gelu_pk((f32x2){v0[0], v0[1]}), b = gelu_pk((f32x2){v0[2], v0[3]}), c = gelu_pk((f32x2){v1[0], v1[1]}), d = gelu_pk((f32x2){v1[2], v1[3]});
                        v0 = (f32x4){a.x, a.y, b.x, b.y}; v1 = (f32x4){c.x, c.y, d.x, d.y}; }
                    if (ACT == 2) { for (int q_ = 0; q_ < 4; ++q_) { const float a_ = fmaxf(v0[q_], 0.f), b_ = fmaxf(v1[q_], 0.f); v0[q_] = a_ * a_; v1[q_] = b_ * b_; } }
                    v0 = v0 * sc; v1 = v1 * sc; u32x4 w; w.x = cvt_pk_bf16(v0[0], v0[1]); w.y = cvt_pk_bf16(v0[2], v0[3]); w.z = cvt_pk_bf16(v1[0], v1[1]); w.w = cvt_pk_bf16(v1[2], v1[3]);
                    *(u32x4*)(rowp + bj * HALF) = w; } }
    }
};
struct EpiResGate {
    static constexpr bool PERM = false, AFTER_DRAIN = false;
    const float* base; float* out; int ldc; const float* gate; int gstride; int tiles_per_batch;
    __device__ __forceinline__ void operator()(const f32x4 (&acc)[2][2][4][2], const Unit& u, int wr, int wc, int fr, int fq) const {
        const int b = u.pm / tiles_per_batch;
        const int col0 = u.pn * BM + wc * 32 + 4 * fq;
        f32x4 gv[2][2];
#pragma unroll
        for (int bj = 0; bj < 2; ++bj)
#pragma unroll
            for (int n = 0; n < 2; ++n) gv[bj][n] = *(const f32x4*)(gate + (size_t)b * gstride + col0 + bj * HALF + n * 16);
#pragma unroll
        for (int ai = 0; ai < 2; ++ai)
#pragma unroll
            for (int m = 0; m < 4; ++m) { const size_t off = (size_t)(u.pm * BM + ai * HALF + wr * 64 + m * 16 + fr) * ldc + col0;
#pragma unroll
                for (int bj = 0; bj < 2; ++bj)
#pragma unroll
                    for (int n = 0; n < 2; ++n) { const f32x4 bs = *(const f32x4*)(base + off + bj * HALF + n * 16);
                        *(f32x4*)(out + off + bj * HALF + n * 16) = bs + gv[bj][n] * acc[ai][bj][m][n]; }
                if (m & 1) asm volatile("" ::: "memory"); }
    }
};

template <class Epi, class Sched, bool ALIGN_EPI = false, bool SP2 = false>
__device__ __forceinline__ void gemm_phase(PG8_LAS unsigned char* lds, const Gemm g, const Sched& S, const Epi& E) {
    const int tid = threadIdx.x, wid = __builtin_amdgcn_readfirstlane(tid >> 6), lane = tid & 63, wr = wid >> 2, wc = wid & 3, fr = lane & 15, fq = lane >> 4;
    const int K = g.K, nt = K / BK;
    unsigned voffA[2], voffB[2];
#pragma unroll
    for (int i = 0; i < 2; ++i) { int R, C; stage_rc(tid * 16 + i * 8192, R, C); const int Rb = Epi::PERM ? ((R & ~31) + perm32(R & 31)) : R;
        voffA[i] = (unsigned)(R * K + C) * 2u; voffB[i] = (unsigned)(Rb * K + C) * 2u; }
    const size_t kstep = (size_t)(BK * 2);
    const size_t hstep = (size_t)HALF * K * 2;
    const size_t tstep = 2 * hstep;
    const unsigned ldsw = (unsigned)wid * 1024u;
    const int aoff = lds_byte(wr * 64 + fr, fq * 8), boff = lds_byte(wc * 32 + fr, fq * 8);
#define PG8_SA(b, h) (((b) * 2 + (h)) * HTB)
#define PG8_SB(b, h) ((4 + (b) * 2 + (h)) * HTB)
#define PG8_STAGE(bufoff, gbase, voff) do { _Pragma("unroll") for (int _i = 0; _i < 2; ++_i) \
        __builtin_amdgcn_global_load_lds((const unsigned*)((const char*)(gbase) + (voff)[_i]), (PG8_LAS unsigned*)(lds + (bufoff) + ldsw + _i * 8192), 16, 0, 0); } while (0)
#define PG8_LDA(dst, b, h) do { _Pragma("unroll") for (int m = 0; m < 4; ++m) _Pragma("unroll") for (int k = 0; k < 2; ++k) dst[m][k] = *(const PG8_LAS bf16x8*)(lds + PG8_SA(b, h) + aoff + m * 2048 + k * 1024); } while (0)
#define PG8_LDB(dst, b, h) do { _Pragma("unroll") for (int n = 0; n < 2; ++n) _Pragma("unroll") for (int k = 0; k < 2; ++k) dst[n][k] = *(const PG8_LAS bf16x8*)(lds + PG8_SB(b, h) + boff + n * 2048 + k * 1024); } while (0)
#define PG8_MMA(ai, bj, At, Bt) do { __builtin_amdgcn_s_setprio(1); _Pragma("unroll") for (int m = 0; m < 4; ++m) _Pragma("unroll") for (int n = 0; n < 2; ++n) _Pragma("unroll") for (int k = 0; k < 2; ++k) \
        acc[ai][bj][m][n] = __builtin_amdgcn_mfma_f32_16x16x32_bf16(Bt[n][k], At[m][k], acc[ai][bj][m][n], 0, 0, 0); __builtin_amdgcn_s_setprio(0); } while (0)
#define PG8_WAIT_V(n) asm volatile("s_waitcnt vmcnt(" #n ")" ::: "memory")
#define PG8_WAIT_L(n) asm volatile("s_waitcnt lgkmcnt(" #n ")" ::: "memory")
#define PG8_BAR __builtin_amdgcn_s_barrier()
#define PG8_SCHED __builtin_amdgcn_sched_barrier(0)
    Unit cur, nxt; int ui = 0;
    if (!S.next(0, cur)) return;
    f32x4 acc[2][2][4][2];
#pragma unroll
    for (int a = 0; a < 2; ++a)
#pragma unroll
        for (int b = 0; b < 2; ++b)
#pragma unroll
            for (int m = 0; m < 4; ++m)
#pragma unroll
                for (int n = 0; n < 2; ++n) acc[a][b][m][n] = (f32x4){0.f, 0.f, 0.f, 0.f};
    bf16x8 At[4][2], B0[2][2], B1[2][2];
    const char* cA = (const char*)g.A + (size_t)cur.pm * tstep; const char* cB = (const char*)g.Bt + (size_t)cur.pn * tstep;
    S.a_ready(cur);
    if constexpr (SP2) {
        PG8_STAGE(PG8_SB(0, 0), cB, voffB); PG8_STAGE(PG8_SB(0, 1), cB + hstep, voffB); PG8_STAGE(PG8_SA(0, 0), cA, voffA); PG8_STAGE(PG8_SA(0, 1), cA + hstep, voffA);
        if (wr == 1) PG8_BAR;
        PG8_WAIT_V(2); PG8_BAR;
        PG8_STAGE(PG8_SB(1, 0), cB + kstep, voffB); PG8_STAGE(PG8_SA(1, 0), cA + kstep, voffA); PG8_STAGE(PG8_SB(1, 1), cB + hstep + kstep, voffB);
        PG8_WAIT_V(6); PG8_BAR;
    } else {
        PG8_STAGE(PG8_SB(0, 0), cB, voffB); PG8_STAGE(PG8_SA(0, 0), cA, voffA); PG8_STAGE(PG8_SB(0, 1), cB + hstep, voffB); PG8_STAGE(PG8_SA(0, 1), cA + hstep, voffA);
        if (wr == 1) PG8_BAR;
        PG8_WAIT_V(4); PG8_BAR;
        PG8_STAGE(PG8_SB(1, 0), cB + kstep, voffB); PG8_STAGE(PG8_SA(1, 0), cA + kstep, voffA); PG8_STAGE(PG8_SB(1, 1), cB + hstep + kstep, voffB);
        PG8_WAIT_V(6); PG8_BAR;
    }
    for (;;) {
        const bool has_next = S.next(ui + 1, nxt);
        const char* nA = has_next ? (const char*)g.A + (size_t)nxt.pm * tstep : cA; const char* nB = has_next ? (const char*)g.Bt + (size_t)nxt.pn * tstep : cB;
        for (int t = 0; t < nt; t += 2) {
            const bool last = (t == nt - 2);
            const char* a1 = cA + (size_t)(t + 1) * kstep;
            const char* a2 = last ? nA : cA + (size_t)(t + 2) * kstep; const char* b2 = last ? nB : cB + (size_t)(t + 2) * kstep;
            const char* a3 = a2 + kstep; const char* b3 = b2 + kstep;
            if (last && has_next) S.a_ready(nxt);
            if constexpr (SP2) {
            PG8_LDB(B0, 0, 0); PG8_LDB(B1, 0, 1); PG8_SCHED; PG8_LDA(At, 0, 0); PG8_STAGE(PG8_SA(1, 1), a1 + hstep, voffA);
            PG8_WAIT_V(8); PG8_WAIT_L(0); PG8_BAR; PG8_MMA(0, 0, At, B0); PG8_MMA(0, 1, At, B1); PG8_BAR; PG8_SCHED;
            PG8_LDA(At, 0, 1); PG8_STAGE(PG8_SB(0, 0), b2, voffB); PG8_STAGE(PG8_SB(0, 1), b2 + hstep, voffB); PG8_STAGE(PG8_SA(0, 0), a2, voffA);
            PG8_WAIT_V(8); PG8_WAIT_L(0); PG8_BAR; PG8_MMA(1, 0, At, B0); PG8_MMA(1, 1, At, B1); PG8_BAR; PG8_SCHED;
            PG8_LDB(B0, 1, 0); PG8_LDB(B1, 1, 1); PG8_SCHED; PG8_LDA(At, 1, 0); PG8_STAGE(PG8_SA(0, 1), a2 + hstep, voffA);
            PG8_WAIT_V(8); PG8_WAIT_L(0); PG8_BAR; PG8_MMA(0, 0, At, B0); PG8_MMA(0, 1, At, B1); PG8_BAR; PG8_SCHED;
            PG8_LDA(At, 1, 1); PG8_STAGE(PG8_SB(1, 0), b3, voffB); PG8_STAGE(PG8_SB(1, 1), b3 + hstep, voffB); PG8_STAGE(PG8_SA(1, 0), a3, voffA);
            PG8_WAIT_V(8); PG8_WAIT_L(0); PG8_BAR; PG8_MMA(1, 0, At, B0); PG8_MMA(1, 1, At, B1); PG8_BAR; PG8_SCHED;
            } else {
            PG8_LDB(B0, 0, 0); PG8_SCHED; PG8_LDA(At, 0, 0); PG8_STAGE(PG8_SA(1, 1), a1 + hstep, voffA);
            PG8_WAIT_L(8); PG8_BAR; PG8_WAIT_L(0); PG8_MMA(0, 0, At, B0); PG8_BAR; PG8_SCHED;
            PG8_LDB(B1, 0, 1); PG8_STAGE(PG8_SB(0, 0), b2, voffB);
            PG8_BAR; PG8_WAIT_L(0); PG8_MMA(0, 1, At, B1); PG8_BAR;
            PG8_LDA(At, 0, 1); PG8_STAGE(PG8_SA(0, 0), a2, voffA);
            PG8_BAR; PG8_WAIT_L(0); PG8_MMA(1, 0, At, B0); PG8_BAR; PG8_SCHED;
            PG8_STAGE(PG8_SB(0, 1), b2 + hstep, voffB);
            PG8_WAIT_V(6); PG8_BAR; PG8_MMA(1, 1, At, B1); PG8_BAR;
            PG8_LDB(B0, 1, 0); PG8_SCHED; PG8_LDA(At, 1, 0); PG8_STAGE(PG8_SA(0, 1), a2 + hstep, voffA);
            PG8_WAIT_L(8); PG8_BAR; PG8_WAIT_L(0); PG8_MMA(0, 0, At, B0); PG8_BAR; PG8_SCHED;
            PG8_LDB(B1, 1, 1); PG8_STAGE(PG8_SB(1, 0), b3, voffB);
            PG8_BAR; PG8_WAIT_L(0); PG8_MMA(0, 1, At, B1); PG8_BAR;
            PG8_LDA(At, 1, 1); PG8_STAGE(PG8_SA(1, 0), a3, voffA);
            PG8_BAR; PG8_WAIT_L(0); PG8_MMA(1, 0, At, B0); PG8_BAR; PG8_SCHED;
            PG8_STAGE(PG8_SB(1, 1), b3 + hstep, voffB);
            PG8_WAIT_V(6); PG8_BAR; PG8_MMA(1, 1, At, B1); PG8_BAR;
            }
        }
        if constexpr (ALIGN_EPI) { if (wr == 0) PG8_BAR; }
        if constexpr (!Epi::AFTER_DRAIN) { E(acc, cur, wr, wc, fr, fq); S.done(cur); }
        if (!has_next) break;
#pragma unroll
        for (int a = 0; a < 2; ++a)
#pragma unroll
            for (int b = 0; b < 2; ++b)
#pragma unroll
                for (int m = 0; m < 4; ++m)
#pragma unroll
                    for (int n = 0; n < 2; ++n) acc[a][b][m][n] = (f32x4){0.f, 0.f, 0.f, 0.f};
        cur = nxt; cA = nA; cB = nB; ++ui;
        if constexpr (ALIGN_EPI) { if (wr == 1) PG8_BAR; }
    }
    PG8_WAIT_V(0);
    if constexpr (!ALIGN_EPI) { if (wr == 0) PG8_BAR; }
    PG8_BAR;
    if constexpr (Epi::AFTER_DRAIN) { E.fused(acc, cur, wr, wc, fr, fq, lds, wid, lane); S.done(cur); }
#undef PG8_SA
#undef PG8_SB
#undef PG8_STAGE
#undef PG8_LDA
#undef PG8_LDB
#undef PG8_MMA
#undef PG8_WAIT_V
#undef PG8_WAIT_L
#undef PG8_BAR
#undef PG8_SCHED
}
}

constexpr int NWAVES = 8;
constexpr int BATCH = 8, SEQ = 4096, D = 1024, DIN = 2560, FF = 4096, M = BATCH * SEQ;
constexpr int NMOD = 6 * D, SCW = 512, LRW = 512;
constexpr float EPS = 1e-6f;
constexpr int O_SCB = 0, O_SCC = 512, O_SCX = 1024, O_LY = 1536, O_LX = 2048;

constexpr size_t MiB = 1u << 20;
constexpr size_t WS_CTL = 0;
constexpr size_t WS_MOD = 1 * MiB;
constexpr size_t WS_GC = WS_MOD + 256 * 1024;
constexpr size_t WS_F = 2 * MiB;
constexpr size_t WS_WIN = 4 * MiB, WS_WOUT = 10 * MiB, WS_WUP = 12 * MiB, WS_WDN = 20 * MiB;
constexpr size_t WS_XN = 32 * MiB;
constexpr size_t WS_PROJ = 96 * MiB;
constexpr size_t WS_Y = 256 * MiB;
constexpr size_t WS_H = 96 * MiB;
constexpr size_t WS_END = 352 * MiB;

constexpr int LDS_BYTES = 147456;

#define LAS __attribute__((address_space(3)))
typedef unsigned short bf16;
typedef unsigned v4u __attribute__((ext_vector_type(4)));
typedef unsigned v2u __attribute__((ext_vector_type(2)));
typedef float f32x4 __attribute__((ext_vector_type(4)));
typedef float f32x16 __attribute__((ext_vector_type(16)));
typedef short bf16x8 __attribute__((ext_vector_type(8)));

__device__ __forceinline__ unsigned f2bf(float f) { unsigned u = __builtin_bit_cast(unsigned, f); return (u + 0x7fffu + ((u >> 16) & 1u)) >> 16; }
__device__ __forceinline__ unsigned pk2(float lo, float hi) { return f2bf(lo) | (f2bf(hi) << 16); }
__device__ __forceinline__ float bflo(unsigned w) { return __builtin_bit_cast(float, w << 16); }
__device__ __forceinline__ float bfhi(unsigned w) { return __builtin_bit_cast(float, w & 0xffff0000u); }
__device__ __forceinline__ float wave_sum(float v) {
#pragma unroll
    for (int o = 1; o < 64; o <<= 1) v += __shfl_xor(v, o);
    return v;
}
__device__ __forceinline__ float sigmoidf_(float v) { return 1.0f / (1.0f + __expf(-v)); }

__device__ __forceinline__ void p0_transpose_item(const float* W, int K, int N, bf16* WT, LAS float* scr, int item, int lane) {
    const int nblk = N / 32, kb = item / nblk, nb = item % nblk, k0 = 64 * kb, n0 = 32 * nb;
#pragma unroll 8
    for (int i = 0; i < 32; ++i) { const int kk = 2 * i + (lane >> 5); scr[kk * 33 + (lane & 31)] = W[(size_t)(k0 + kk) * N + n0 + (lane & 31)]; }
    asm volatile("s_waitcnt lgkmcnt(0)" ::: "memory");
    const int c = lane & 7;
#pragma unroll
    for (int j = 0; j < 4; ++j) { const int n = (lane >> 3) + 8 * j; const LAS float* s = scr + (8 * c) * 33 + n;
        v4u o; o.x = pk2(s[0 * 33], s[1 * 33]); o.y = pk2(s[2 * 33], s[3 * 33]); o.z = pk2(s[4 * 33], s[5 * 33]); o.w = pk2(s[6 * 33], s[7 * 33]);
        *(v4u*)(WT + (size_t)(n0 + n) * K + k0 + 8 * c) = o; }
    asm volatile("s_waitcnt lgkmcnt(0)" ::: "memory");
}

#define XB_TMO      128
#define XB_XCNT(j)  (256  + 64 * (j))
#define XB_XSUB(j)  (1280 + 64 * (j))
#define XB_XGEN(j)  (2304 + 64 * (j))
#define XB_TOP      3328
#define XB_TOPGEN   3392
#define XCD_BAR_WORDS 3456
#define XB_SPIN_CAP (1u << 18)

__device__ __forceinline__ unsigned xb_ld(unsigned* p)              { return __hip_atomic_load(p, __ATOMIC_RELAXED, __HIP_MEMORY_SCOPE_AGENT); }
__device__ __forceinline__ unsigned xb_add(unsigned* p, unsigned v) { return __hip_atomic_fetch_add(p, v, __ATOMIC_RELAXED, __HIP_MEMORY_SCOPE_AGENT); }
__device__ __forceinline__ unsigned xb_xcc_id() { return (unsigned)__builtin_amdgcn_s_getreg((3 << 11) | 20) & 0xFu; }
#define XB_SPIN(cond, bar) do { unsigned _sp = 0; while (cond) { __builtin_amdgcn_s_sleep(1); \
    if ((++_sp & 255u) == 0u) { if (xb_ld(&(bar)[XB_TMO])) break; if (_sp > XB_SPIN_CAP) { atomicAdd(&(bar)[XB_TMO], 1u); break; } } } } while (0)

struct XcdBarrier {
    unsigned* bar; unsigned x;
    volatile LAS unsigned* st;
};

__device__ __forceinline__ XcdBarrier xcd_barrier_post(unsigned* bar, volatile LAS unsigned* st) {
    XcdBarrier b; b.bar = bar; b.x = xb_xcc_id(); b.st = st;
    if (threadIdx.x == 0) (void)xb_add(&bar[XB_XCNT(b.x)], 1u);
    return b;
}
__device__ __forceinline__ void xcd_barrier_complete(unsigned* bar, unsigned x, unsigned& nloc, unsigned& nx) {
    const unsigned G = gridDim.x * gridDim.y * gridDim.z;
    unsigned sum, cnt, mine, sp = 0u;
    for (;;) {
        sum = 0u; cnt = 0u; mine = 0u;
#pragma unroll
        for (unsigned j = 0; j < 16; ++j) { const unsigned c = xb_ld(&bar[XB_XCNT(j)]); sum += c; cnt += (c > 0u) ? 1u : 0u; mine = (j == x) ? c : mine; }
        if (sum == G) break;
        __builtin_amdgcn_s_sleep(1);
        if ((++sp & 255u) == 0u) { if (xb_ld(&bar[XB_TMO])) break; if (sp > XB_SPIN_CAP) { atomicAdd(&bar[XB_TMO], 1u); break; } }
    }
    nloc = mine > 0u ? mine : 1u; nx = cnt > 0u ? cnt : 1u;
}

__device__ __forceinline__ void xcd_barrier(const XcdBarrier& b) {
    asm volatile("s_waitcnt vmcnt(0)" ::: "memory");
    __syncthreads();
    if (threadIdx.x == 0) {
        unsigned* bar = b.bar;
        __builtin_amdgcn_s_waitcnt(0);
        unsigned nloc = b.st[0], nx = b.st[1];
        if (nloc == 0u) { xcd_barrier_complete(bar, b.x, nloc, nx); b.st[0] = nloc; b.st[1] = nx; }
        const unsigned old = xb_add(&bar[XB_XSUB(b.x)], 1u);
        const unsigned gen = old / nloc;
        if (old + 1u == (gen + 1u) * nloc) {
            __builtin_amdgcn_fence(__ATOMIC_RELEASE, "agent");
            asm volatile("s_waitcnt vmcnt(0)" ::: "memory");
            const unsigned og = xb_add(&bar[XB_TOP], 1u);
            const unsigned tg = og / nx;
            if (og + 1u == (tg + 1u) * nx) xb_add(&bar[XB_TOPGEN], 1u);
            else XB_SPIN(xb_ld(&bar[XB_TOPGEN]) == tg, bar);
            __builtin_amdgcn_fence(__ATOMIC_ACQUIRE, "agent");
            xb_add(&bar[XB_XGEN(b.x)], 1u);
            asm volatile("s_waitcnt vmcnt(0)" ::: "memory");
        } else {
            XB_SPIN(xb_ld(&bar[XB_XGEN(b.x)]) == gen, bar);
            __builtin_amdgcn_fence(__ATOMIC_ACQUIRE, "agent");
            asm volatile("s_waitcnt vmcnt(0)" ::: "memory");
        }
    }
    __syncthreads();
}

struct Args { const float* in[19]; float* out; unsigned char* ws; };

__device__ __forceinline__ void norm_mod_phase(const float* X, bf16* XN, const float* g, const float* sc, const float* sh, int gw, int NGW, int lane) {
    for (int gi = gw; gi < M / 16; gi += NGW) {
        const int b = gi >> 8;
        f32x4 S[4], Hh[4];
#pragma unroll
        for (int j = 0; j < 4; ++j) { const int col = 4 * lane + 256 * j; const f32x4 gv = *(const f32x4*)(g + col), sv = *(const f32x4*)(sc + (size_t)b * NMOD + col);
            S[j] = gv * (sv + 1.0f); Hh[j] = *(const f32x4*)(sh + (size_t)b * NMOD + col); }
#pragma unroll 4
        for (int r = 0; r < 16; ++r) {
            const size_t row = (size_t)gi * 16 + r;
            const f32x4* xr = (const f32x4*)(X + row * D) + lane;
            f32x4 v[4]; float s = 0.f;
#pragma unroll
            for (int j = 0; j < 4; ++j) { v[j] = xr[64 * j]; s += (v[j].x * v[j].x + v[j].y * v[j].y) + (v[j].z * v[j].z + v[j].w * v[j].w); }
            const float rstd = 1.0f / sqrtf(wave_sum(s) * (1.0f / D) + EPS);
            v2u* o8 = (v2u*)(XN + row * D) + lane;
#pragma unroll
            for (int j = 0; j < 4; ++j) { const f32x4 o = v[j] * rstd * S[j] + Hh[j]; v2u w; w.x = pk2(o.x, o.y); w.y = pk2(o.z, o.w); o8[64 * j] = w; }
        }
    }
}
__device__ __forceinline__ void final_norm_phase(float* X, const float* g, int gw, int NGW, int lane) {
    f32x4 S[4];
#pragma unroll
    for (int j = 0; j < 4; ++j) S[j] = *(const f32x4*)(g + 4 * lane + 256 * j);
    for (int gi = gw; gi < M / 16; gi += NGW) {
#pragma unroll 4
        for (int r = 0; r < 16; ++r) {
            const size_t row = (size_t)gi * 16 + r;
            f32x4* xr = (f32x4*)(X + row * D) + lane;
            f32x4 v[4]; float s = 0.f;
#pragma unroll
            for (int j = 0; j < 4; ++j) { v[j] = xr[64 * j]; s += (v[j].x * v[j].x + v[j].y * v[j].y) + (v[j].z * v[j].z + v[j].w * v[j].w); }
            const float rstd = 1.0f / sqrtf(wave_sum(s) * (1.0f / D) + EPS);
#pragma unroll
            for (int j = 0; j < 4; ++j) xr[64 * j] = v[j] * rstd * S[j];
        }
    }
}

__device__ __forceinline__ void unpack8(const v4u w, float (&f)[8]) { f[0] = bflo(w.x); f[1] = bfhi(w.x); f[2] = bflo(w.y); f[3] = bfhi(w.y); f[4] = bflo(w.z); f[5] = bfhi(w.z); f[6] = bflo(w.w); f[7] = bfhi(w.w); }
__device__ __forceinline__ void sc_phase(const bf16* PROJ, bf16* Y, const float* wsc, int gw, int NGW, int lane) {
    float w0[8], w1[8], w2[8];
#pragma unroll
    for (int e = 0; e < 8; ++e) { w0[e] = wsc[0 * SCW + 8 * lane + e]; w1[e] = wsc[1 * SCW + 8 * lane + e]; w2[e] = wsc[2 * SCW + 8 * lane + e]; }
    for (int wi = gw; wi < M / 16; wi += NGW) {
        const size_t row0 = (size_t)wi * 16;
        float p1[8], p2[8];
        if ((row0 & (SEQ - 1)) == 0) {
#pragma unroll
            for (int e = 0; e < 8; ++e) { p1[e] = 0.f; p2[e] = 0.f; }
        } else {
            float c[8], x[8];
            unpack8(*(const v4u*)(PROJ + (row0 - 2) * DIN + O_SCC + 8 * lane), c); unpack8(*(const v4u*)(PROJ + (row0 - 2) * DIN + O_SCX + 8 * lane), x);
#pragma unroll
            for (int e = 0; e < 8; ++e) p2[e] = c[e] * x[e];
            unpack8(*(const v4u*)(PROJ + (row0 - 1) * DIN + O_SCC + 8 * lane), c); unpack8(*(const v4u*)(PROJ + (row0 - 1) * DIN + O_SCX + 8 * lane), x);
#pragma unroll
            for (int e = 0; e < 8; ++e) p1[e] = c[e] * x[e];
        }
#pragma unroll 4
        for (int r = 0; r < 16; ++r) {
            const size_t row = row0 + r;
            float bq[8], c[8], x[8], y[8];
            unpack8(*(const v4u*)(PROJ + row * DIN + O_SCB + 8 * lane), bq);
            unpack8(*(const v4u*)(PROJ + row * DIN + O_SCC + 8 * lane), c);
            unpack8(*(const v4u*)(PROJ + row * DIN + O_SCX + 8 * lane), x);
#pragma unroll
            for (int e = 0; e < 8; ++e) { const float p0 = c[e] * x[e]; y[e] = bq[e] * (w0[e] * p2[e] + w1[e] * p1[e] + w2[e] * p0); p2[e] = p1[e]; p1[e] = p0; }
            v4u o; o.x = pk2(y[0], y[1]); o.y = pk2(y[2], y[3]); o.z = pk2(y[4], y[5]); o.w = pk2(y[6], y[7]);
            *(v4u*)(Y + row * D + 8 * lane) = o;
        }
    }
}

template <int CTRL, int RMASK> __device__ __forceinline__ float dpp_old(float oldv, float v) {
    return __builtin_bit_cast(float, __builtin_amdgcn_update_dpp(__builtin_bit_cast(int, oldv), __builtin_bit_cast(int, v), CTRL, RMASK, 0xf, false));
}
#define SCAN_STEP(CTRL, RMASK) do { _Pragma("unroll") for (int e = 0; e < 8; ++e) { const float aL = dpp_old<CTRL, RMASK>(1.0f, a[e]), bL = dpp_old<CTRL, RMASK>(0.0f, bb[e]); bb[e] = a[e] * bL + bb[e]; a[e] = aL * a[e]; } } while (0)
__device__ __forceinline__ float gelu_tanh(float v) {
    const float z = 0.7978845608028654f * (v + 0.044715f * v * v * v);
    const float t = 1.0f - 2.0f / (__expf(2.0f * z) + 1.0f);
    return 0.5f * v * (1.0f + t);
}
__device__ __forceinline__ void lru_phase(LAS unsigned char* lds, const bf16* PROJ, bf16* Y, const bf16* Fw, const float* GC, const float* wl_g, const float* cb_g, const float* lam_g, int G, int tid, int wave, int lane) {
    LAS bf16x8* Fl = (LAS bf16x8*)lds;
    LAS float* carry = (LAS float*)(lds + 16384);
    volatile LAS int* flag = (volatile LAS int*)(lds + 16384 + 129 * 64);
    const int n = lane & 31, h = lane >> 5;
    for (int unit = blockIdx.x; unit < 256; unit += G) {
        const int b = unit >> 5, head = (unit >> 2) & 7, q = unit & 3;
        __syncthreads();
        { const v4u* Fg = (const v4u*)Fw + (size_t)(head * 4 + q) * 1024; LAS v4u* Fd = (LAS v4u*)lds;
          for (int i = tid; i < 1024; i += NWAVES * 64) Fd[i] = Fg[i]; }
        for (int i = tid; i < 129; i += NWAVES * 64) flag[i] = (i == 0) ? 1 : 0;
        if (tid < 16) carry[tid] = 0.f;
        __syncthreads();
        const int chb = 64 * head + 16 * q + 8 * h;
        float ca[8], cx[8], sp8[8], cb[8], wl[4][8];
#pragma unroll
        for (int e = 0; e < 8; ++e) { const int ch = chb + e;
            ca[e] = GC[(head * 2 + 0) * 64 + 16 * q + 8 * h + e]; cx[e] = GC[(head * 2 + 1) * 64 + 16 * q + 8 * h + e];
            sp8[e] = -8.0f * log1pf(expf(-lam_g[ch])); cb[e] = cb_g[ch];
#pragma unroll
            for (int j = 0; j < 4; ++j) wl[j][e] = wl_g[j * LRW + ch]; }
        const bf16* P = PROJ + (size_t)b * SEQ * DIN;
        for (int g = wave; g < SEQ / 32; g += NWAVES) {
            const int t = 32 * g + n;
            bf16x8 fr[4][4]; v4u xo[4];
#pragma unroll
            for (int j = 0; j < 4; ++j) { const int tt = t - 3 + j; const bool ok = tt >= 0; const bf16* rp = P + (size_t)(ok ? tt : 0) * DIN + O_LX;
#pragma unroll
                for (int cs = 0; cs < 4; ++cs) { bf16x8 v = *(const bf16x8*)(rp + 64 * head + 16 * cs + 8 * h); if (!ok) v = (bf16x8){0, 0, 0, 0, 0, 0, 0, 0}; fr[j][cs] = v; }
                v4u xv = *(const v4u*)(rp + chb); if (!ok) xv = (v4u){0u, 0u, 0u, 0u}; xo[j] = xv; }
            const v4u gtv = *(const v4u*)(P + (size_t)t * DIN + O_LY + chb);
            f32x16 acc;
#pragma unroll
            for (int i = 0; i < 16; ++i) acc[i] = 0.f;
#pragma unroll
            for (int j = 0; j < 4; ++j)
#pragma unroll
                for (int cs = 0; cs < 4; ++cs) acc = __builtin_amdgcn_mfma_f32_32x32x16_bf16(Fl[(j * 4 + cs) * 64 + lane], fr[j][cs], acc, 0, 0, 0);
            float a[8], bb[8];
            { float x0[8], x1[8], x2[8], x3[8]; unpack8(xo[0], x0); unpack8(xo[1], x1); unpack8(xo[2], x2); unpack8(xo[3], x3);
#pragma unroll
              for (int e = 0; e < 8; ++e) {
                const float u = cb[e] + wl[0][e] * x0[e] + wl[1][e] * x1[e] + wl[2][e] * x2[e] + wl[3][e] * x3[e];
                const float r = sigmoidf_(acc[e] + ca[e]), ig = sigmoidf_(acc[8 + e] + cx[e]);
                const float la = sp8[e] * r;
                a[e] = __expf(la);
                const float x2l = 2.0f * la;
                const float om = (x2l > -0.03f) ? -(x2l * (1.0f + x2l * (0.5f + x2l * (0.16666667f + x2l * 0.041666668f)))) : (1.0f - __expf(x2l));
                bb[e] = sqrtf(om) * ig * u; } }
            SCAN_STEP(0x111, 0xf); SCAN_STEP(0x112, 0xf); SCAN_STEP(0x114, 0xf); SCAN_STEP(0x118, 0xf); SCAN_STEP(0x142, 0xa);
            while (flag[g] == 0) __builtin_amdgcn_s_sleep(1);
            asm volatile("" ::: "memory");
            float hh[8];
            { const f32x4 c0 = *(const LAS f32x4*)(carry + g * 16 + 8 * h), c1 = *(const LAS f32x4*)(carry + g * 16 + 8 * h + 4);
              const float hin[8] = {c0.x, c0.y, c0.z, c0.w, c1.x, c1.y, c1.z, c1.w};
#pragma unroll
              for (int e = 0; e < 8; ++e) hh[e] = bb[e] + a[e] * hin[e]; }
            if (n == 31) { *(LAS f32x4*)(carry + (g + 1) * 16 + 8 * h) = (f32x4){hh[0], hh[1], hh[2], hh[3]}; *(LAS f32x4*)(carry + (g + 1) * 16 + 8 * h + 4) = (f32x4){hh[4], hh[5], hh[6], hh[7]}; }
            asm volatile("s_waitcnt lgkmcnt(0)" ::: "memory");
            if (lane == 0) flag[g + 1] = 1;
            float gt[8]; unpack8(gtv, gt);
            float y[8];
#pragma unroll
            for (int e = 0; e < 8; ++e) y[e] = gelu_tanh(gt[e]) * hh[e];
            v4u o; o.x = pk2(y[0], y[1]); o.y = pk2(y[2], y[3]); o.z = pk2(y[4], y[5]); o.w = pk2(y[6], y[7]);
            *(v4u*)(Y + ((size_t)b * SEQ + t) * D + SCW + chb) = o;
        }
    }
    __syncthreads();
}

__global__ void __launch_bounds__(NWAVES * 64, 2) fwd_megakernel(Args args) {
    extern __shared__ __attribute__((aligned(16))) unsigned char lds_raw[];
    LAS unsigned char* lds = (LAS unsigned char*)lds_raw;
    cg::grid_group grid = cg::this_grid();
    volatile LAS unsigned* bar_st = (volatile LAS unsigned*)(lds + LDS_BYTES - 64);
    if (threadIdx.x < 16) bar_st[threadIdx.x] = 0u;
    __syncthreads();
    const XcdBarrier xbar = xcd_barrier_post((unsigned*)args.ws, bar_st);
    const int tid = threadIdx.x, lane = tid & 63, wave = __builtin_amdgcn_readfirstlane(tid >> 6);
    const int G = gridDim.x, bx = blockIdx.x;
    const int gw = bx * NWAVES + wave, NGW = G * NWAVES;
    unsigned char* ws = args.ws;
    const float* x = args.in[0]; const float* c_in = args.in[1]; const float* w_ada = args.in[2]; const float* b_ada = args.in[3]; const float* g_mix = args.in[4];
    const float* w_in = args.in[5]; const float* conv_w_sc = args.in[6]; const float* conv_w_lru = args.in[7]; const float* conv_b_lru = args.in[8];
    const float* w_rg_a = args.in[9]; const float* b_rg_a = args.in[10]; const float* w_rg_x = args.in[11]; const float* b_rg_x = args.in[12]; const float* lam = args.in[13];
    const float* w_out = args.in[14]; const float* g_mlp = args.in[15]; const float* w_up = args.in[16]; const float* w_down = args.in[17]; const float* g_final = args.in[18];
    float* out = args.out;
    float* MOD = (float*)(ws + WS_MOD); float* GC = (float*)(ws + WS_GC); bf16* Fw = (bf16*)(ws + WS_F);
    bf16* Win_t = (bf16*)(ws + WS_WIN); bf16* Wout_t = (bf16*)(ws + WS_WOUT); bf16* Wup_t = (bf16*)(ws + WS_WUP); bf16* Wdn_t = (bf16*)(ws + WS_WDN);
    bf16* XN = (bf16*)(ws + WS_XN); bf16* PROJ = (bf16*)(ws + WS_PROJ); bf16* Y = (bf16*)(ws + WS_Y); bf16* HB = (bf16*)(ws + WS_H);

    {
        LAS float* sl = (LAS float*)lds; LAS float* part = sl + 8192;
        for (int item = bx; item < NMOD / 64; item += G) {
            for (int i = tid; i < BATCH * D; i += NWAVES * 64) { const float cv = c_in[i]; sl[i] = cv / (1.0f + __expf(-cv)); }
            __syncthreads();
            const int nn = item * 64 + lane, k0 = wave * 128;
            float acc[8];
#pragma unroll
            for (int b = 0; b < 8; ++b) acc[b] = 0.f;
#pragma unroll 4
            for (int k = k0; k < k0 + 128; ++k) { const float wv = w_ada[(size_t)k * NMOD + nn];
#pragma unroll
                for (int b = 0; b < 8; ++b) acc[b] += sl[b * D + k] * wv; }
#pragma unroll
            for (int b = 0; b < 8; ++b) part[(wave * 8 + b) * 64 + lane] = acc[b];
            __syncthreads();
            float s = b_ada[nn];
#pragma unroll
            for (int w2 = 0; w2 < 8; ++w2) s += part[(w2 * 8 + wave) * 64 + lane];
            MOD[(size_t)wave * NMOD + nn] = s;
            __syncthreads();
        }
        LAS float* scr = (LAS float*)(lds + wave * 16384);
        constexpr int I_IN = (D / 64) * (DIN / 32), I_OUT = (D / 64) * (D / 32), I_UP = (D / 64) * (FF / 32), I_DN = (FF / 64) * (D / 32);
        constexpr int NITEMS = I_IN + I_OUT + I_UP + I_DN;
        for (int it = gw; it < NITEMS; it += NGW) {
            int r = it;
            if (r < I_IN) { p0_transpose_item(w_in, D, DIN, Win_t, scr, r, lane); continue; } r -= I_IN;
            if (r < I_OUT) { p0_transpose_item(w_out, D, D, Wout_t, scr, r, lane); continue; } r -= I_OUT;
            if (r < I_UP) { p0_transpose_item(w_up, D, FF, Wup_t, scr, r, lane); continue; } r -= I_UP;
            p0_transpose_item(w_down, FF, D, Wdn_t, scr, r, lane);
        }
        for (int i = bx * (NWAVES * 64) + tid; i < 32 * 8192; i += G * NWAVES * 64) {
            const int unit = i >> 13, ks = (i >> 9) & 15, ln = (i >> 3) & 63, jj = i & 7;
            const int head = unit >> 2, q = unit & 3, m = ln & 31, k = 16 * ks + 8 * (ln >> 5) + jj, tap = k >> 6, c = k & 63;
            const int mm = m & 15, cho = 16 * q + 8 * ((mm >> 2) & 1) + 4 * (mm >> 3) + (mm & 3);
            const float* Wg = (m >> 4) ? w_rg_x : w_rg_a;
            const float v = conv_w_lru[tap * LRW + 64 * head + c] * Wg[((size_t)head * 64 + c) * 64 + cho];
            Fw[i] = (bf16)f2bf(v);
        }
        for (int i = bx * (NWAVES * 64) + tid; i < 8 * 2 * 64; i += G * NWAVES * 64) {
            const int head = i >> 7, gate = (i >> 6) & 1, o = i & 63;
            const float* Wg = gate ? w_rg_x : w_rg_a; const float* bg = gate ? b_rg_x : b_rg_a;
            float s = bg[head * 64 + o];
            for (int c = 0; c < 64; ++c) s += conv_b_lru[64 * head + c] * Wg[((size_t)head * 64 + c) * 64 + o];
            GC[i] = s;
        }
    }
    grid.sync();
    norm_mod_phase(x, XN, g_mix, MOD + 1 * D, MOD + 0 * D, gw, NGW, lane);
    xcd_barrier(xbar);
    {
        pg8::Gemm g{XN, Win_t, M, DIN, D}; pg8::StaticOrder S; S.init(M, DIN, G, bx);
        pg8::EpiBf16<0> E{PROJ, DIN, nullptr, 0, 0, 1.f};
        pg8::gemm_phase<pg8::EpiBf16<0>, pg8::StaticOrder, true, true>(lds, g, S, E);
    }
    xcd_barrier(xbar);
    sc_phase(PROJ, Y, conv_w_sc, gw, NGW, lane);
    lru_phase(lds, PROJ, Y, Fw, GC, conv_w_lru, conv_b_lru, lam, G, tid, wave, lane);
    xcd_barrier(xbar);
    {
        pg8::Gemm g{Y, Wout_t, M, D, D}; pg8::StaticOrder S; S.init(M, D, G, bx);
        pg8::EpiResGate E{x, out, D, MOD + 2 * D, NMOD, SEQ / 256};
        pg8::gemm_phase<pg8::EpiResGate, pg8::StaticOrder, true, true>(lds, g, S, E);
    }
    xcd_barrier(xbar);
    norm_mod_phase(out, XN, g_mlp, MOD + 4 * D, MOD + 3 * D, gw, NGW, lane);
    xcd_barrier(xbar);
    {
        pg8::Gemm g{XN, Wup_t, M, FF, D}; pg8::StaticOrder S; S.init(M, FF, G, bx);
        pg8::EpiBf16<2> E{HB, FF, nullptr, 0, 0, 1.f};
        pg8::gemm_phase<pg8::EpiBf16<2>, pg8::StaticOrder, true, true>(lds, g, S, E);
    }
    xcd_barrier(xbar);
    {
        pg8::Gemm g{HB, Wdn_t, M, D, FF}; pg8::StaticOrder S; S.init(M, D, G, bx);
        pg8::EpiResGate E{out, out, D, MOD + 5 * D, NMOD, SEQ / 256};
        pg8::gemm_phase<pg8::EpiResGate, pg8::StaticOrder, true, true>(lds, g, S, E);
    }
    xcd_barrier(xbar);
    final_norm_phase(out, g_final, gw, NGW, lane);
}

extern "C" void kernel_launch(void* const* d_in, const int* in_sizes, int n_in, void* d_out, int out_size, void* d_ws, size_t ws_size, hipStream_t stream) {
    static int grid = 0;
    if (grid == 0) {
        if (n_in != 19 || in_sizes[0] != M * D || out_size != M * D || ws_size < WS_END) { fprintf(stderr, "kernel_launch: unexpected shapes (n_in %d, in0 %d, out %d, ws %zu); nothing launched\n", n_in, n_in > 0 ? in_sizes[0] : -1, out_size, ws_size); grid = -1; return; }
        int dev = 0, cus = 0, per_cu = 0;
        if (hipGetDevice(&dev) != hipSuccess || hipDeviceGetAttribute(&cus, hipDeviceAttributeMultiprocessorCount, dev) != hipSuccess) { grid = -1; return; }
        if (hipFuncSetAttribute((const void*)fwd_megakernel, hipFuncAttributeMaxDynamicSharedMemorySize, LDS_BYTES) != hipSuccess) { fprintf(stderr, "kernel_launch: hipFuncSetAttribute failed\n"); grid = -1; return; }
        if (hipOccupancyMaxActiveBlocksPerMultiprocessor(&per_cu, (const void*)fwd_megakernel, NWAVES * 64, LDS_BYTES) != hipSuccess || per_cu < 1) { fprintf(stderr, "kernel_launch: occupancy query gave %d\n", per_cu); per_cu = 1; }
        (void)hipGetLastError();
        grid = cus * per_cu;
    }
    if (grid < 0) return;
    if (hipMemsetAsync(d_ws, 0, 65536, stream) != hipSuccess) { fprintf(stderr, "kernel_launch: memset failed\n"); return; }
    Args a{};
    for (int i = 0; i < 19; ++i) a.in[i] = (const float*)d_in[i];
    a.out = (float*)d_out; a.ws = (unsigned char*)d_ws;
    void* kargs[] = {&a};
    hipError_t e = hipLaunchCooperativeKernel((const void*)fwd_megakernel, dim3(grid), dim3(NWAVES * 64), kargs, LDS_BYTES, stream);
    if (e != hipSuccess) fprintf(stderr, "kernel_launch: cooperative launch failed: %s (grid %d)\n", hipGetErrorString(e), grid);
}
```

```cpp
#include <hip/hip_runtime.h>
#include <hip/hip_cooperative_groups.h>
#include <cstdio>
#include <cstdint>
namespace cg = cooperative_groups;
namespace pg8 {
#define PG8_LAS __attribute__((address_space(3)))
typedef unsigned short bf16_t;
typedef short bf16x8 __attribute__((ext_vector_type(8)));
typedef float f32x4 __attribute__((ext_vector_type(4)));
typedef unsigned u32x4 __attribute__((ext_vector_type(4)));
constexpr int BM = 256, BK = 64, HALF = 128, HTB = HALF * BK * 2  , STAGE_BYTES = 8 * HTB, NXCD = 8, WGM = 8;

__host__ __device__ __forceinline__ int lds_byte(int r, int c) { const int st = (r >> 4) * 2 + (c >> 5), rr = r & 15, cc = c & 31, ob = rr * 64 + cc * 2; return st * 1024 + (ob ^ (((ob >> 9) & 1) << 5)); }
__host__ __device__ __forceinline__ void stage_rc(int b, int& R, int& C) { const int st = b / 1024, sb = b % 1024, swz = sb ^ (((sb >> 9) & 1) << 5); R = (st >> 1) * 16 + swz / 64; C = (st & 1) * 32 + (swz % 64) / 2; }
__host__ __device__ __forceinline__ int perm32(int rho) { const int n = rho >> 4, i = rho & 15; return 8 * (i >> 2) + 4 * n + (i & 3); }

struct Unit { int pm, pn; };
struct Gemm { const bf16_t* A; const bf16_t* Bt; int M, N, K; };

struct StaticOrder {
    int nM, nN, nwg, G, c;
    __host__ __device__ void init(int M, int N, int G_, int c_) { nM = M / BM; nN = N / BM; nwg = nM * nN; G = G_; c = c_; }
    __host__ __device__ bool next(int i, Unit& u) const {
        const long L = (long)i * G + c; if (L >= nwg) return false;
        int wgid = (int)L; { const int q = nwg / NXCD, r = nwg % NXCD, xcd = wgid % NXCD, off = wgid / NXCD; wgid = (xcd < r ? xcd * (q + 1) : r * (q + 1) + (xcd - r) * q) + off; }
        const int nig = WGM * nN, gid = wgid / nig, fm = gid * WGM, gsz = (nM - fm) < WGM ? (nM - fm) : WGM;
        u.pm = fm + ((wgid % nig) % gsz); u.pn = (wgid % nig) / gsz; return true;
    }
    __device__ __forceinline__ void a_ready(const Unit&) const {}
    __device__ __forceinline__ void done(const Unit&) const {}
};

__device__ __forceinline__ unsigned cvt_pk_bf16(float lo, float hi) { unsigned r; asm volatile("v_cvt_pk_bf16_f32 %0, %1, %2" : "=v"(r) : "v"(lo), "v"(hi)); return r; }
typedef float f32x2 __attribute__((ext_vector_type(2)));
__device__ __forceinline__ f32x2 gelu_pk(f32x2 v) {
    const f32x2 av = __builtin_elementwise_abs(v), d = av * 0.2316418882f + 1.0f;
    f32x2 t; t.x = __builtin_amdgcn_rcpf(d.x); t.y = __builtin_amdgcn_rcpf(d.y);
    f32x2 q = t * 0.5307027145f + (-0.7265760135f); q = q * t + 0.7107068705f; q = q * t + (-0.142248368f); q = q * t + 0.127414796f; q = q * t;
    const f32x2 s = (v * v) * (-0.72134752044f);
    f32x2 e; e.x = __builtin_amdgcn_exp2f(s.x); e.y = __builtin_amdgcn_exp2f(s.y);
    const f32x2 m = v * (q * e), r = v - m;
    f32x2 o; o.x = v.x < 0.f ? m.x : r.x; o.y = v.y < 0.f ? m.y : r.y; return o;
}

template <int ACT  > struct EpiBf16 {
    static constexpr bool PERM = true, AFTER_DRAIN = false; static_assert(ACT == 0 || ACT == 1 || ACT == 2, "EpiBf16: ACT is 0 (none), 1 (gelu_pk) or 2 (squared relu)");
    bf16_t* O; int ldc; const float* bias; int split_cols; size_t split_stride; float scale0;
    __device__ __forceinline__ void operator()(const f32x4 (&acc)[2][2][4][2], const Unit& u, int wr, int wc, int fr, int fq) const {
        const int row0 = u.pm * BM + wr * 64 + fr; int colt = u.pn * BM; bf16_t* base = O;
        float sc = 1.f; if (split_cols) { const int t = colt / split_cols; base += (size_t)t * split_stride; colt -= t * split_cols; if (t == 0) sc = scale0; }
        const int col0 = colt + wc * 32 + 8 * fq, bcol0 = u.pn * BM + wc * 32 + 8 * fq;
        f32x4 bv[2][2];
#pragma unroll
        for (int bj = 0; bj < 2; ++bj)
#pragma unroll
            for (int n = 0; n < 2; ++n) bv[bj][n] = bias ? *(const f32x4*)(bias + bcol0 + bj * HALF + 4 * n) : (f32x4){0.f, 0.f, 0.f, 0.f};
#pragma unroll
        for (int ai = 0; ai < 2; ++ai)
#pragma unroll
            for (int m = 0; m < 4; ++m) { bf16_t* rowp = base + (size_t)(row0 + ai * HALF + m * 16) * ldc + col0;
#pragma unroll
                for (int bj = 0; bj < 2; ++bj) { f32x4 v0 = acc[ai][bj][m][0] + bv[bj][0], v1 = acc[ai][bj][m][1] + bv[bj][1];
                    if (ACT == 1) { f32x2 a = gelu_pk((f32x2){v0[0], v0[1]}), b = gelu_pk((f32x2){v0[2], v0[3]}), c = gelu_pk((f32x2){v1[0], v1[1]}), d = gelu_pk((f32x2){v1[2], v1[3]});
                        v0 = (f32x4){a.x, a.y, b.x, b.y}; v1 = (f32x4){c.x, c.y, d.x, d.y}; }
                    if (ACT == 2) { for (int q_ = 0; q_ < 4; ++q_) { const float a_ = fmaxf(v0[q_], 0.f), b_ = fmaxf(v1[q_], 0.f); v0[q_] = a_ * a_; v1[q_] = b_ * b_; } }
                    v0 = v0 * sc; v1 = v1 * sc; u32x4 w; w.x = cvt_pk_bf16(v0[0], v0[1]); w.y = cvt_pk_bf16(v0[2], v0[3]); w.z = cvt_pk_bf16(v1[0], v1[1]); w.w = cvt_pk_bf16(v1[2], v1[3]);
                    *(u32x4*)(rowp + bj * HALF) = w; } }
    }
};
struct EpiResGate {
    static constexpr bool PERM = false, AFTER_DRAIN = false;
    const float* base; float* out; int ldc; const float* gate; int gstride; int tiles_per_batch;
    __device__ __forceinline__ void operator()(const f32x4 (&acc)[2][2][4][2], const Unit& u, int wr, int wc, int fr, int fq) const {
        const int b = u.pm / tiles_per_batch;
        const int col0 = u.pn * BM + wc * 32 + 4 * fq;
        f32x4 gv[2][2];
#pragma unroll
        for (int bj = 0; bj < 2; ++bj)
#pragma unroll
            for (int n = 0; n < 2; ++n) gv[bj][n] = *(const f32x4*)(gate + (size_t)b * gstride + col0 + bj * HALF + n * 16);
#pragma unroll
        for (int ai = 0; ai < 2; ++ai)
#pragma unroll
            for (int m = 0; m < 4; ++m) { const size_t off = (size_t)(u.pm * BM + ai * HALF + wr * 64 + m * 16 + fr) * ldc + col0;
#pragma unroll
                for (int bj = 0; bj < 2; ++bj)
#pragma unroll
                    for (int n = 0; n < 2; ++n) { const f32x4 bs = *(const f32x4*)(base + off + bj * HALF + n * 16);
                        *(f32x4*)(out + off + bj * HALF + n * 16) = bs + gv[bj][n] * acc[ai][bj][m][n]; }
                if (m & 1) asm volatile("" ::: "memory"); }
    }
};

template <class Epi, class Sched, bool ALIGN_EPI = false, bool SP2 = false>
__device__ __forceinline__ void gemm_phase(PG8_LAS unsigned char* lds, const Gemm g, const Sched& S, const Epi& E) {
    int tid_ = threadIdx.x; asm volatile("" : "+v"(tid_));
    const int tid = tid_, wid = __builtin_amdgcn_readfirstlane(tid >> 6), lane = tid & 63, wr = wid >> 2, wc = wid & 3, fr = lane & 15, fq = lane >> 4;
    const int K = g.K, nt = K / BK;
    unsigned voffA[2], voffB[2];
#pragma unroll
    for (int i = 0; i < 2; ++i) { int R, C; stage_rc(tid * 16 + i * 8192, R, C); const int Rb = Epi::PERM ? ((R & ~31) + perm32(R & 31)) : R;
        voffA[i] = (unsigned)(R * K + C) * 2u; voffB[i] = (unsigned)(Rb * K + C) * 2u; }
    const size_t kstep = (size_t)(BK * 2);
    const size_t hstep = (size_t)HALF * K * 2;
    const size_t tstep = 2 * hstep;
    const unsigned ldsw = (unsigned)wid * 1024u;
    const int aoff = lds_byte(wr * 64 + fr, fq * 8), boff = lds_byte(wc * 32 + fr, fq * 8);
#define PG8_SA(b, h) (((b) * 2 + (h)) * HTB)
#define PG8_SB(b, h) ((4 + (b) * 2 + (h)) * HTB)
#define PG8_STAGE(bufoff, gbase, voff) do { _Pragma("unroll") for (int _i = 0; _i < 2; ++_i) \
        __builtin_amdgcn_global_load_lds((const unsigned*)((const char*)(gbase) + (voff)[_i]), (PG8_LAS unsigned*)(lds + (bufoff) + ldsw + _i * 8192), 16, 0, 0); } while (0)
#define PG8_LDA(dst, b, h) do { _Pragma("unroll") for (int m = 0; m < 4; ++m) _Pragma("unroll") for (int k = 0; k < 2; ++k) dst[m][k] = *(const PG8_LAS bf16x8*)(lds + PG8_SA(b, h) + aoff + m * 2048 + k * 1024); } while (0)
#define PG8_LDB(dst, b, h) do { _Pragma("unroll") for (int n = 0; n < 2; ++n) _Pragma("unroll") for (int k = 0; k < 2; ++k) dst[n][k] = *(const PG8_LAS bf16x8*)(lds + PG8_SB(b, h) + boff + n * 2048 + k * 1024); } while (0)
#define PG8_MMA(ai, bj, At, Bt) do { __builtin_amdgcn_s_setprio(1); _Pragma("unroll") for (int m = 0; m < 4; ++m) _Pragma("unroll") for (int n = 0; n < 2; ++n) _Pragma("unroll") for (int k = 0; k < 2; ++k) \
        acc[ai][bj][m][n] = __builtin_amdgcn_mfma_f32_16x16x32_bf16(Bt[n][k], At[m][k], acc[ai][bj][m][n], 0, 0, 0); __builtin_amdgcn_s_setprio(0); } while (0)
#define PG8_WAIT_V(n) asm volatile("s_waitcnt vmcnt(" #n ")" ::: "memory")
#define PG8_WAIT_L(n) asm volatile("s_waitcnt lgkmcnt(" #n ")" ::: "memory")
#define PG8_BAR __builtin_amdgcn_s_barrier()
#define PG8_SCHED __builtin_amdgcn_sched_barrier(0)
    Unit cur, nxt; int ui = 0;
    if (!S.next(0, cur)) return;
    f32x4 acc[2][2][4][2];
#pragma unroll
    for (int a = 0; a < 2; ++a)
#pragma unroll
        for (int b = 0; b < 2; ++b)
#pragma unroll
            for (int m = 0; m < 4; ++m)
#pragma unroll
                for (int n = 0; n < 2; ++n) acc[a][b][m][n] = (f32x4){0.f, 0.f, 0.f, 0.f};
    bf16x8 At[4][2], B0[2][2], B1[2][2];
    const char* cA = (const char*)g.A + (size_t)cur.pm * tstep; const char* cB = (const char*)g.Bt + (size_t)cur.pn * tstep;
    S.a_ready(cur);
    if constexpr (SP2) {
        PG8_STAGE(PG8_SB(0, 0), cB, voffB); PG8_STAGE(PG8_SB(0, 1), cB + hstep, voffB); PG8_STAGE(PG8_SA(0, 0), cA, voffA); PG8_STAGE(PG8_SA(0, 1), cA + hstep, voffA);
        if (wr == 1) PG8_BAR;
        PG8_WAIT_V(2); PG8_BAR;
        PG8_STAGE(PG8_SB(1, 0), cB + kstep, voffB); PG8_STAGE(PG8_SA(1, 0), cA + kstep, voffA); PG8_STAGE(PG8_SB(1, 1), cB + hstep + kstep, voffB);
        PG8_WAIT_V(6); PG8_BAR;
    } else {
        PG8_STAGE(PG8_SB(0, 0), cB, voffB); PG8_STAGE(PG8_SA(0, 0), cA, voffA); PG8_STAGE(PG8_SB(0, 1), cB + hstep, voffB); PG8_STAGE(PG8_SA(0, 1), cA + hstep, voffA);
        if (wr == 1) PG8_BAR;
        PG8_WAIT_V(4); PG8_BAR;
        PG8_STAGE(PG8_SB(1, 0), cB + kstep, voffB); PG8_STAGE(PG8_SA(1, 0), cA + kstep, voffA); PG8_STAGE(PG8_SB(1, 1), cB + hstep + kstep, voffB);
        PG8_WAIT_V(6); PG8_BAR;
    }
    for (;;) {
        const bool has_next = S.next(ui + 1, nxt);
        const char* nA = has_next ? (const char*)g.A + (size_t)nxt.pm * tstep : cA; const char* nB = has_next ? (const char*)g.Bt + (size_t)nxt.pn * tstep : cB;
        for (int t = 0; t < nt; t += 2) {
            const bool last = (t == nt - 2);
            const char* a1 = cA + (size_t)(t + 1) * kstep;
            const char* a2 = last ? nA : cA + (size_t)(t + 2) * kstep; const char* b2 = last ? nB : cB + (size_t)(t + 2) * kstep;
            const char* a3 = a2 + kstep; const char* b3 = b2 + kstep;
            if (last && has_next) S.a_ready(nxt);
            if constexpr (SP2) {
            PG8_LDB(B0, 0, 0); PG8_LDB(B1, 0, 1); PG8_SCHED; PG8_LDA(At, 0, 0); PG8_STAGE(PG8_SA(1, 1), a1 + hstep, voffA);
            PG8_WAIT_V(8); PG8_WAIT_L(0); PG8_BAR; PG8_MMA(0, 0, At, B0); PG8_MMA(0, 1, At, B1); PG8_BAR; PG8_SCHED;
            PG8_LDA(At, 0, 1); PG8_STAGE(PG8_SB(0, 0), b2, voffB); PG8_STAGE(PG8_SB(0, 1), b2 + hstep, voffB); PG8_STAGE(PG8_SA(0, 0), a2, voffA);
            PG8_WAIT_V(8); PG8_WAIT_L(0); PG8_BAR; PG8_MMA(1, 0, At, B0); PG8_MMA(1, 1, At, B1); PG8_BAR; PG8_SCHED;
            PG8_LDB(B0, 1, 0); PG8_LDB(B1, 1, 1); PG8_SCHED; PG8_LDA(At, 1, 0); PG8_STAGE(PG8_SA(0, 1), a2 + hstep, voffA);
            PG8_WAIT_V(8); PG8_WAIT_L(0); PG8_BAR; PG8_MMA(0, 0, At, B0); PG8_MMA(0, 1, At, B1); PG8_BAR; PG8_SCHED;
            PG8_LDA(At, 1, 1); PG8_STAGE(PG8_SB(1, 0), b3, voffB); PG8_STAGE(PG8_SB(1, 1), b3 + hstep, voffB); PG8_STAGE(PG8_SA(1, 0), a3, voffA);
            PG8_WAIT_V(8); PG8_WAIT_L(0); PG8_BAR; PG8_MMA(1, 0, At, B0); PG8_MMA(1, 1, At, B1); PG8_BAR; PG8_SCHED;
            } else {
            PG8_LDB(B0, 0, 0); PG8_SCHED; PG8_LDA(At, 0, 0); PG8_STAGE(PG8_SA(1, 1), a1 + hstep, voffA);
            PG8_WAIT_L(8); PG8_BAR; PG8_WAIT_L(0); PG8_MMA(0, 0, At, B0); PG8_BAR; PG8_SCHED;
            PG8_LDB(B1, 0, 1); PG8_STAGE(PG8_SB(0, 0), b2, voffB);
            PG8_BAR; PG8_WAIT_L(0); PG8_MMA(0, 1, At, B1); PG8_BAR;
            PG8_LDA(At, 0, 1); PG8_STAGE(PG8_SA(0, 0), a2, voffA);
            PG8_BAR; PG8_WAIT_L(0); PG8_MMA(1, 0, At, B0); PG8_BAR; PG8_SCHED;
            PG8_STAGE(PG8_SB(0, 1), b2 + hstep, voffB);
            PG8_WAIT_V(6); PG8_BAR; PG8_MMA(1, 1, At, B1); PG8_BAR;
            PG8_LDB(B0, 1, 0); PG8_SCHED; PG8_LDA(At, 1, 0); PG8_STAGE(PG8_SA(0, 1), a2 + hstep, voffA);
            PG8_WAIT_L(8); PG8_BAR; PG8_WAIT_L(0); PG8_MMA(0, 0, At, B0); PG8_BAR; PG8_SCHED;
            PG8_LDB(B1, 1, 1); PG8_STAGE(PG8_SB(1, 0), b3, voffB);
            PG8_BAR; PG8_WAIT_L(0); PG8_MMA(0, 1, At, B1); PG8_BAR;
            PG8_LDA(At, 1, 1); PG8_STAGE(PG8_SA(1, 0), a3, voffA);
            PG8_BAR; PG8_WAIT_L(0); PG8_MMA(1, 0, At, B0); PG8_BAR; PG8_SCHED;
            PG8_STAGE(PG8_SB(1, 1), b3 + hstep, voffB);
            PG8_WAIT_V(6); PG8_BAR; PG8_MMA(1, 1, At, B1); PG8_BAR;
            }
        }
        if constexpr (ALIGN_EPI) { if (wr == 0) PG8_BAR; }
        if constexpr (!Epi::AFTER_DRAIN) { E(acc, cur, wr, wc, fr, fq); S.done(cur); }
        if (!has_next) break;
#pragma unroll
        for (int a = 0; a < 2; ++a)
#pragma unroll
            for (int b = 0; b < 2; ++b)
#pragma unroll
                for (int m = 0; m < 4; ++m)
#pragma unroll
                    for (int n = 0; n < 2; ++n) acc[a][b][m][n] = (f32x4){0.f, 0.f, 0.f, 0.f};
        cur = nxt; cA = nA; cB = nB; ++ui;
        if constexpr (ALIGN_EPI) { if (wr == 1) PG8_BAR; }
    }
    PG8_WAIT_V(0);
    if constexpr (!ALIGN_EPI) { if (wr == 0) PG8_BAR; }
    PG8_BAR;
    if constexpr (Epi::AFTER_DRAIN) { E.fused(acc, cur, wr, wc, fr, fq, lds, wid, lane); S.done(cur); }
#undef PG8_SA
#undef PG8_SB
#undef PG8_STAGE
#undef PG8_LDA
#undef PG8_LDB
#undef PG8_MMA
#undef PG8_WAIT_V
#undef PG8_WAIT_L
#undef PG8_BAR
#undef PG8_SCHED
}
}

constexpr int NWAVES = 8;
constexpr int BATCH = 8, SEQ = 4096, D = 1024, DIN = 2560, FF = 4096, M = BATCH * SEQ;
constexpr int NMOD = 6 * D, SCW = 512, LRW = 512;
constexpr float EPS = 1e-6f;
constexpr int O_SCB = 0, O_SCC = 512, O_SCX = 1024, O_LY = 1536, O_LX = 2048;

constexpr size_t MiB = 1u << 20;
constexpr size_t WS_CTL = 0;
constexpr size_t WS_MOD = 1 * MiB;
constexpr size_t WS_GC = WS_MOD + 256 * 1024;
constexpr size_t WS_F = 2 * MiB;
constexpr size_t WS_WIN = 4 * MiB, WS_WOUT = 10 * MiB, WS_WUP = 12 * MiB, WS_WDN = 20 * MiB;
constexpr size_t WS_XN = 32 * MiB;
constexpr size_t WS_PROJ = 96 * MiB;
constexpr size_t WS_Y = 256 * MiB;
constexpr size_t WS_H = 96 * MiB;
constexpr size_t WS_END = 352 * MiB;

constexpr int LDS_BYTES = 147456;

#define LAS __attribute__((address_space(3)))
typedef unsigned short bf16;
typedef unsigned v4u __attribute__((ext_vector_type(4)));
typedef unsigned v2u __attribute__((ext_vector_type(2)));
typedef float f32x4 __attribute__((ext_vector_type(4)));
typedef float f32x16 __attribute__((ext_vector_type(16)));
typedef short bf16x8 __attribute__((ext_vector_type(8)));

__device__ __forceinline__ unsigned f2bf(float f) { unsigned u = __builtin_bit_cast(unsigned, f); return (u + 0x7fffu + ((u >> 16) & 1u)) >> 16; }
__device__ __forceinline__ unsigned pk2(float lo, float hi) { return f2bf(lo) | (f2bf(hi) << 16); }
__device__ __forceinline__ float bflo(unsigned w) { return __builtin_bit_cast(float, w << 16); }
__device__ __forceinline__ float bfhi(unsigned w) { return __builtin_bit_cast(float, w & 0xffff0000u); }
__device__ __forceinline__ float wave_sum(float v) {
#pragma unroll
    for (int o = 1; o < 64; o <<= 1) v += __shfl_xor(v, o);
    return v;
}
__device__ __forceinline__ float sigmoidf_(float v) { return 1.0f / (1.0f + __expf(-v)); }

__device__ __forceinline__ void p0_transpose_item(const float* W, int K, int N, bf16* WT, LAS float* scr, int item, int lane) {
    const int nblk = N / 32, kb = item / nblk, nb = item % nblk, k0 = 64 * kb, n0 = 32 * nb;
#pragma unroll 8
    for (int i = 0; i < 32; ++i) { const int kk = 2 * i + (lane >> 5); scr[kk * 33 + (lane & 31)] = W[(size_t)(k0 + kk) * N + n0 + (lane & 31)]; }
    asm volatile("s_waitcnt lgkmcnt(0)" ::: "memory");
    const int c = lane & 7;
#pragma unroll
    for (int j = 0; j < 4; ++j) { const int n = (lane >> 3) + 8 * j; const LAS float* s = scr + (8 * c) * 33 + n;
        v4u o; o.x = pk2(s[0 * 33], s[1 * 33]); o.y = pk2(s[2 * 33], s[3 * 33]); o.z = pk2(s[4 * 33], s[5 * 33]); o.w = pk2(s[6 * 33], s[7 * 33]);
        *(v4u*)(WT + (size_t)(n0 + n) * K + k0 + 8 * c) = o; }
    asm volatile("s_waitcnt lgkmcnt(0)" ::: "memory");
}

#define XB_TMO      128
#define XB_XCNT(j)  (256  + 64 * (j))
#define XB_XSUB(j)  (1280 + 64 * (j))
#define XB_XGEN(j)  (2304 + 64 * (j))
#define XB_TOP      3328
#define XB_TOPGEN   3392
#define XCD_BAR_WORDS 3456
#define XB_SPIN_CAP (1u << 18)

__device__ __forceinline__ unsigned xb_ld(unsigned* p)              { return __hip_atomic_load(p, __ATOMIC_RELAXED, __HIP_MEMORY_SCOPE_AGENT); }
__device__ __forceinline__ unsigned xb_add(unsigned* p, unsigned v) { return __hip_atomic_fetch_add(p, v, __ATOMIC_RELAXED, __HIP_MEMORY_SCOPE_AGENT); }
__device__ __forceinline__ unsigned xb_xcc_id() { return (unsigned)__builtin_amdgcn_s_getreg((3 << 11) | 20) & 0xFu; }
#define XB_SPIN(cond, bar) do { unsigned _sp = 0; while (cond) { __builtin_amdgcn_s_sleep(1); \
    if ((++_sp & 255u) == 0u) { if (xb_ld(&(bar)[XB_TMO])) break; if (_sp > XB_SPIN_CAP) { atomicAdd(&(bar)[XB_TMO], 1u); break; } } } } while (0)

struct XcdBarrier {
    unsigned* bar; unsigned x;
    volatile LAS unsigned* st;
};

__device__ __forceinline__ XcdBarrier xcd_barrier_post(unsigned* bar, volatile LAS unsigned* st) {
    XcdBarrier b; b.bar = bar; b.x = xb_xcc_id(); b.st = st;
    if (threadIdx.x == 0) (void)xb_add(&bar[XB_XCNT(b.x)], 1u);
    return b;
}
__device__ __forceinline__ void xcd_barrier_complete(unsigned* bar, unsigned x, unsigned& nloc, unsigned& nx) {
    const unsigned G = gridDim.x * gridDim.y * gridDim.z;
    unsigned sum, cnt, mine, sp = 0u;
    for (;;) {
        sum = 0u; cnt = 0u; mine = 0u;
#pragma unroll
        for (unsigned j = 0; j < 16; ++j) { const unsigned c = xb_ld(&bar[XB_XCNT(j)]); sum += c; cnt += (c > 0u) ? 1u : 0u; mine = (j == x) ? c : mine; }
        if (sum == G) break;
        __builtin_amdgcn_s_sleep(1);
        if ((++sp & 255u) == 0u) { if (xb_ld(&bar[XB_TMO])) break; if (sp > XB_SPIN_CAP) { atomicAdd(&bar[XB_TMO], 1u); break; } }
    }
    nloc = mine > 0u ? mine : 1u; nx = cnt > 0u ? cnt : 1u;
}

__device__ __forceinline__ void xcd_barrier(const XcdBarrier& b) {
    asm volatile("s_waitcnt vmcnt(0)" ::: "memory");
    __syncthreads();
    if (threadIdx.x == 0) {
        unsigned* bar = b.bar;
        __builtin_amdgcn_s_waitcnt(0);
        unsigned nloc = b.st[0], nx = b.st[1];
        if (nloc == 0u) { xcd_barrier_complete(bar, b.x, nloc, nx); b.st[0] = nloc; b.st[1] = nx; }
        const unsigned old = xb_add(&bar[XB_XSUB(b.x)], 1u);
        const unsigned gen = old / nloc;
        if (old + 1u == (gen + 1u) * nloc) {
            __builtin_amdgcn_fence(__ATOMIC_RELEASE, "agent");
            asm volatile("s_waitcnt vmcnt(0)" ::: "memory");
            const unsigned og = xb_add(&bar[XB_TOP], 1u);
            const unsigned tg = og / nx;
            if (og + 1u == (tg + 1u) * nx) xb_add(&bar[XB_TOPGEN], 1u);
            else XB_SPIN(xb_ld(&bar[XB_TOPGEN]) == tg, bar);
            __builtin_amdgcn_fence(__ATOMIC_ACQUIRE, "agent");
            xb_add(&bar[XB_XGEN(b.x)], 1u);
            asm volatile("s_waitcnt vmcnt(0)" ::: "memory");
        } else {
            XB_SPIN(xb_ld(&bar[XB_XGEN(b.x)]) == gen, bar);
            __builtin_amdgcn_fence(__ATOMIC_ACQUIRE, "agent");
            asm volatile("s_waitcnt vmcnt(0)" ::: "memory");
        }
    }
    __syncthreads();
}

struct Args { const float* in[19]; float* out; unsigned char* ws; };

__device__ __forceinline__ void norm_mod_phase(const float* X, bf16* XN, const float* g, const float* sc, const float* sh, int gw, int NGW, int lane) {
    for (int gi = gw; gi < M / 16; gi += NGW) {
        const int b = gi >> 8;
        f32x4 S[4], Hh[4];
#pragma unroll
        for (int j = 0; j < 4; ++j) { const int col = 4 * lane + 256 * j; const f32x4 gv = *(const f32x4*)(g + col), sv = *(const f32x4*)(sc + (size_t)b * NMOD + col);
            S[j] = gv * (sv + 1.0f); Hh[j] = *(const f32x4*)(sh + (size_t)b * NMOD + col); }
#pragma unroll 4
        for (int r = 0; r < 16; ++r) {
            const size_t row = (size_t)gi * 16 + r;
            const f32x4* xr = (const f32x4*)(X + row * D) + lane;
            f32x4 v[4]; float s = 0.f;
#pragma unroll
            for (int j = 0; j < 4; ++j) { v[j] = xr[64 * j]; s += (v[j].x * v[j].x + v[j].y * v[j].y) + (v[j].z * v[j].z + v[j].w * v[j].w); }
            const float rstd = 1.0f / sqrtf(wave_sum(s) * (1.0f / D) + EPS);
            v2u* o8 = (v2u*)(XN + row * D) + lane;
#pragma unroll
            for (int j = 0; j < 4; ++j) { const f32x4 o = v[j] * rstd * S[j] + Hh[j]; v2u w; w.x = pk2(o.x, o.y); w.y = pk2(o.z, o.w); o8[64 * j] = w; }
        }
    }
}
__device__ __forceinline__ void final_norm_phase(float* X, const float* g, int gw, int NGW, int lane) {
    f32x4 S[4];
#pragma unroll
    for (int j = 0; j < 4; ++j) S[j] = *(const f32x4*)(g + 4 * lane + 256 * j);
    for (int gi = gw; gi < M / 16; gi += NGW) {
#pragma unroll 4
        for (int r = 0; r < 16; ++r) {
            const size_t row = (size_t)gi * 16 + r;
            f32x4* xr = (f32x4*)(X + row * D) + lane;
            f32x4 v[4]; float s = 0.f;
#pragma unroll
            for (int j = 0; j < 4; ++j) { v[j] = xr[64 * j]; s += (v[j].x * v[j].x + v[j].y * v[j].y) + (v[j].z * v[j].z + v[j].w * v[j].w); }
            const float rstd = 1.0f / sqrtf(wave_sum(s) * (1.0f / D) + EPS);
#pragma unroll
            for (int j = 0; j < 4; ++j) xr[64 * j] = v[j] * rstd * S[j];
        }
    }
}

__device__ __forceinline__ void unpack8(const v4u w, float (&f)[8]) { f[0] = bflo(w.x); f[1] = bfhi(w.x); f[2] = bflo(w.y); f[3] = bfhi(w.y); f[4] = bflo(w.z); f[5] = bfhi(w.z); f[6] = bflo(w.w); f[7] = bfhi(w.w); }
__device__ __forceinline__ void sc_phase(const bf16* PROJ, bf16* Y, const float* wsc, int gw, int NGW, int lane) {
    float w0[8], w1[8], w2[8];
#pragma unroll
    for (int e = 0; e < 8; ++e) { w0[e] = wsc[0 * SCW + 8 * lane + e]; w1[e] = wsc[1 * SCW + 8 * lane + e]; w2[e] = wsc[2 * SCW + 8 * lane + e]; }
    for (int wi = gw; wi < M / 16; wi += NGW) {
        const size_t row0 = (size_t)wi * 16;
        float p1[8], p2[8];
        if ((row0 & (SEQ - 1)) == 0) {
#pragma unroll
            for (int e = 0; e < 8; ++e) { p1[e] = 0.f; p2[e] = 0.f; }
        } else {
            float c[8], x[8];
            unpack8(*(const v4u*)(PROJ + (row0 - 2) * DIN + O_SCC + 8 * lane), c); unpack8(*(const v4u*)(PROJ + (row0 - 2) * DIN + O_SCX + 8 * lane), x);
#pragma unroll
            for (int e = 0; e < 8; ++e) p2[e] = c[e] * x[e];
            unpack8(*(const v4u*)(PROJ + (row0 - 1) * DIN + O_SCC + 8 * lane), c); unpack8(*(const v4u*)(PROJ + (row0 - 1) * DIN + O_SCX + 8 * lane), x);
#pragma unroll
            for (int e = 0; e < 8; ++e) p1[e] = c[e] * x[e];
        }
#pragma unroll 4
        for (int r = 0; r < 16; ++r) {
            const size_t row = row0 + r;
            float bq[8], c[8], x[8], y[8];
            unpack8(*(const v4u*)(PROJ + row * DIN + O_SCB + 8 * lane), bq);
            unpack8(*(const v4u*)(PROJ + row * DIN + O_SCC + 8 * lane), c);
            unpack8(*(const v4u*)(PROJ + row * DIN + O_SCX + 8 * lane), x);
#pragma unroll
            for (int e = 0; e < 8; ++e) { const float p0 = c[e] * x[e]; y[e] = bq[e] * (w0[e] * p2[e] + w1[e] * p1[e] + w2[e] * p0); p2[e] = p1[e]; p1[e] = p0; }
            v4u o; o.x = pk2(y[0], y[1]); o.y = pk2(y[2], y[3]); o.z = pk2(y[4], y[5]); o.w = pk2(y[6], y[7]);
            *(v4u*)(Y + row * D + 8 * lane) = o;
        }
    }
}

template <int CTRL, int RMASK> __device__ __forceinline__ float dpp_old(float oldv, float v) {
    return __builtin_bit_cast(float, __builtin_amdgcn_update_dpp(__builtin_bit_cast(int, oldv), __builtin_bit_cast(int, v), CTRL, RMASK, 0xf, false));
}
#define SCAN_STEP(CTRL, RMASK) do { _Pragma("unroll") for (int e = 0; e < 8; ++e) { const float aL = dpp_old<CTRL, RMASK>(1.0f, a[e]), bL = dpp_old<CTRL, RMASK>(0.0f, bb[e]); bb[e] = a[e] * bL + bb[e]; a[e] = aL * a[e]; } } while (0)
__device__ __forceinline__ float rcp_(float v) { return __builtin_amdgcn_rcpf(v); }
__device__ __forceinline__ float sigm_(float v) { return rcp_(1.0f + __expf(-v)); }
__device__ __forceinline__ float gelu_tanh(float v) {
    const float z = 0.7978845608028654f * (v + 0.044715f * v * v * v);
    const float t = 1.0f - 2.0f * rcp_(__expf(2.0f * z) + 1.0f);
    return 0.5f * v * (1.0f + t);
}
constexpr int LRU_TROW = 144, LRU_TREG = 34 * LRU_TROW, LRU_TWAVE = 10240, LRU_TOFF = 32768, LRU_NG = SEQ / 64;
__device__ __forceinline__ void lru_load_tile(v4u (&R)[9], v4u (&GT)[2], const bf16* P, int g, int head, int chb, int lane, int n) {
    const int t0 = 64 * g;
#pragma unroll
    for (int i = 0; i < 9; ++i) { const int id = 64 * i + lane, row = id >> 3, cc = id & 7, tt = t0 - 3 + row; const bool ok = (row < 67) && (tt >= 0);
        v4u v = (v4u){0u, 0u, 0u, 0u}; if (ok) v = *(const v4u*)(P + (size_t)tt * DIN + O_LX + 64 * head + 8 * cc); R[i] = v; }
#pragma unroll
    for (int tau = 0; tau < 2; ++tau) GT[tau] = *(const v4u*)(P + (size_t)(t0 + 2 * n + tau) * DIN + O_LY + chb);
}
__device__ __forceinline__ void lru_phase(LAS unsigned char* lds, const bf16* PROJ, bf16* Y, const bf16* Fw, const float* GC, const float* wl_g, const float* cb_g, const float* lam_g, int G, int tid, int wave, int lane) {
    LAS bf16x8* Fl = (LAS bf16x8*)lds;
    LAS float* carry = (LAS float*)(lds + 16384);
    volatile LAS int* flag = (volatile LAS int*)(lds + 16384 + 65 * 64);
    LAS unsigned char* tile = lds + LRU_TOFF + wave * LRU_TWAVE;
    LAS float* ctab = (LAS float*)(lds + 24576);
    const int n = lane & 31, h = lane >> 5;
    for (int unit = blockIdx.x; unit < 256; unit += G) {
        const int q = (unit >> 3) & 3, bh = (unit & 7) | ((unit >> 5) << 3), b = bh >> 3, head = bh & 7;
        __syncthreads();
        { const v4u* Fg = (const v4u*)Fw + (size_t)(head * 4 + q) * 1024; LAS v4u* Fd = (LAS v4u*)lds;
          for (int i = tid; i < 1024; i += NWAVES * 64) Fd[i] = Fg[i]; }
        for (int i = tid; i < 65; i += NWAVES * 64) flag[i] = (i == 0) ? 1 : 0;
        if (tid < 16) carry[tid] = 0.f;
        if (tid < 80) { const int hh = tid / 40, r = tid % 40, jj = r >> 3, e = r & 7, ch = 64 * head + 16 * q + 8 * hh + e;
            ctab[tid] = (jj == 0) ? cb_g[ch] : wl_g[(jj - 1) * LRW + ch]; }
        __syncthreads();
        const int chb = 64 * head + 16 * q + 8 * h;
        float ca[8], cx[8], sp8[8];
#pragma unroll
        for (int e = 0; e < 8; ++e) { const int ch = chb + e;
            ca[e] = GC[(head * 2 + 0) * 64 + 16 * q + 8 * h + e]; cx[e] = GC[(head * 2 + 1) * 64 + 16 * q + 8 * h + e];
            sp8[e] = -8.0f * log1pf(expf(-lam_g[ch])); }
        const bf16* P = PROJ + (size_t)b * SEQ * DIN;
        v4u R[9], GT[2];
        lru_load_tile(R, GT, P, wave, head, chb, lane, n);
        for (int g = wave; g < LRU_NG; g += NWAVES) {
            const int t0 = 64 * g;
#pragma unroll
            for (int i = 0; i < 9; ++i) { const int id = 64 * i + lane, row = id >> 3, cc = id & 7; if (row < 68) *(LAS v4u*)(tile + (row & 1) * LRU_TREG + (row >> 1) * LRU_TROW + cc * 16) = R[i]; }
            const v4u gt0 = GT[0], gt1 = GT[1];
            if (g + NWAVES < LRU_NG) lru_load_tile(R, GT, P, g + NWAVES, head, chb, lane, n);
            f32x16 acc0, acc1;
#pragma unroll
            for (int i = 0; i < 16; ++i) { acc0[i] = 0.f; acc1[i] = 0.f; }
#pragma unroll
            for (int j = 0; j < 4; ++j)
#pragma unroll
                for (int cs = 0; cs < 4; ++cs) {
                    const bf16x8 af = Fl[(j * 4 + cs) * 64 + lane];
                    const bf16x8 f0 = *(const LAS bf16x8*)(tile + (j & 1) * LRU_TREG + (n + (j >> 1)) * LRU_TROW + 32 * cs + 16 * h);
                    const bf16x8 f1 = *(const LAS bf16x8*)(tile + ((j + 1) & 1) * LRU_TREG + (n + ((j + 1) >> 1)) * LRU_TROW + 32 * cs + 16 * h);
                    acc0 = __builtin_amdgcn_mfma_f32_32x32x16_bf16(af, f0, acc0, 0, 0, 0);
                    acc1 = __builtin_amdgcn_mfma_f32_32x32x16_bf16(af, f1, acc1, 0, 0, 0);
                    if (cs & 1) __builtin_amdgcn_sched_barrier(0);
                }
            float a0[8], b0[8], a[8], bb[8];
#pragma unroll
            for (int tau = 0; tau < 2; ++tau) {
                float xs[4][8];
#pragma unroll
                for (int j = 0; j < 4; ++j) unpack8(*(const LAS v4u*)(tile + ((tau + j) & 1) * LRU_TREG + (n + ((tau + j) >> 1)) * LRU_TROW + 32 * q + 16 * h), xs[j]);
                float cw[5][8];
#pragma unroll
                for (int j = 0; j < 5; ++j) { const f32x4 c0 = *(const LAS f32x4*)(ctab + h * 40 + j * 8), c1 = *(const LAS f32x4*)(ctab + h * 40 + j * 8 + 4);
                    cw[j][0] = c0.x; cw[j][1] = c0.y; cw[j][2] = c0.z; cw[j][3] = c0.w; cw[j][4] = c1.x; cw[j][5] = c1.y; cw[j][6] = c1.z; cw[j][7] = c1.w; }
#pragma unroll
                for (int e = 0; e < 8; ++e) {
                    const float u = cw[0][e] + cw[1][e] * xs[0][e] + cw[2][e] * xs[1][e] + cw[3][e] * xs[2][e] + cw[4][e] * xs[3][e];
                    const float pa = tau ? acc1[e] : acc0[e], px = tau ? acc1[8 + e] : acc0[8 + e];
                    const float r = sigm_(pa + ca[e]), ig = sigm_(px + cx[e]);
                    const float la = sp8[e] * r;
                    const float av = __expf(la);
                    const float x2l = 2.0f * la;
                    const float om = (x2l > -0.03f) ? -(x2l * (1.0f + x2l * (0.5f + x2l * (0.16666667f + x2l * 0.041666668f)))) : (1.0f - av * av);
                    const float bv = __builtin_amdgcn_sqrtf(om) * ig * u;
                    if (tau == 0) { a0[e] = av; b0[e] = bv; } else { a[e] = a0[e] * av; bb[e] = av * b0[e] + bv; }
                }
            }
            SCAN_STEP(0x111, 0xf); SCAN_STEP(0x112, 0xf); SCAN_STEP(0x114, 0xf); SCAN_STEP(0x118, 0xf); SCAN_STEP(0x142, 0xa);
            while (flag[g] == 0) __builtin_amdgcn_s_sleep(1);
            asm volatile("" ::: "memory");
            float h1[8], hin[8];
            { const f32x4 c0 = *(const LAS f32x4*)(carry + g * 16 + 8 * h), c1 = *(const LAS f32x4*)(carry + g * 16 + 8 * h + 4);
              hin[0] = c0.x; hin[1] = c0.y; hin[2] = c0.z; hin[3] = c0.w; hin[4] = c1.x; hin[5] = c1.y; hin[6] = c1.z; hin[7] = c1.w;
#pragma unroll
              for (int e = 0; e < 8; ++e) h1[e] = bb[e] + a[e] * hin[e]; }
            if (n == 31) { *(LAS f32x4*)(carry + (g + 1) * 16 + 8 * h) = (f32x4){h1[0], h1[1], h1[2], h1[3]}; *(LAS f32x4*)(carry + (g + 1) * 16 + 8 * h + 4) = (f32x4){h1[4], h1[5], h1[6], h1[7]}; }
            asm volatile("s_waitcnt lgkmcnt(0)" ::: "memory");
            if (lane == 0) flag[g + 1] = 1;
            float g0[8], g1[8]; unpack8(gt0, g0); unpack8(gt1, g1);
            float y0[8], y1[8];
#pragma unroll
            for (int e = 0; e < 8; ++e) {
                float hp = dpp_old<0x138, 0xf>(0.0f, h1[e]);
                if (n == 0) hp = hin[e];
                const float h0 = a0[e] * hp + b0[e];
                y0[e] = gelu_tanh(g0[e]) * h0; y1[e] = gelu_tanh(g1[e]) * h1[e];
            }
            v4u o0, o1; o0.x = pk2(y0[0], y0[1]); o0.y = pk2(y0[2], y0[3]); o0.z = pk2(y0[4], y0[5]); o0.w = pk2(y0[6], y0[7]);
            o1.x = pk2(y1[0], y1[1]); o1.y = pk2(y1[2], y1[3]); o1.z = pk2(y1[4], y1[5]); o1.w = pk2(y1[6], y1[7]);
            bf16* yp = Y + ((size_t)b * SEQ + t0 + 2 * n) * D + SCW + chb;
            *(v4u*)yp = o0; *(v4u*)(yp + D) = o1;
        }
    }
    __syncthreads();
}

__global__ void __launch_bounds__(NWAVES * 64, 2) fwd_megakernel(Args args) {
    extern __shared__ __attribute__((aligned(16))) unsigned char lds_raw[];
    LAS unsigned char* lds = (LAS unsigned char*)lds_raw;
    cg::grid_group grid = cg::this_grid();
    volatile LAS unsigned* bar_st = (volatile LAS unsigned*)(lds + LDS_BYTES - 64);
    if (threadIdx.x < 16) bar_st[threadIdx.x] = 0u;
    __syncthreads();
    const XcdBarrier xbar = xcd_barrier_post((unsigned*)args.ws, bar_st);
    const int tid = threadIdx.x, lane = tid & 63, wave = __builtin_amdgcn_readfirstlane(tid >> 6);
    const int G = gridDim.x, bx = blockIdx.x;
    const int gw = bx * NWAVES + wave, NGW = G * NWAVES;
    unsigned char* ws = args.ws;
    const float* x = args.in[0]; const float* c_in = args.in[1]; const float* w_ada = args.in[2]; const float* b_ada = args.in[3]; const float* g_mix = args.in[4];
    const float* w_in = args.in[5]; const float* conv_w_sc = args.in[6]; const float* conv_w_lru = args.in[7]; const float* conv_b_lru = args.in[8];
    const float* w_rg_a = args.in[9]; const float* b_rg_a = args.in[10]; const float* w_rg_x = args.in[11]; const float* b_rg_x = args.in[12]; const float* lam = args.in[13];
    const float* w_out = args.in[14]; const float* g_mlp = args.in[15]; const float* w_up = args.in[16]; const float* w_down = args.in[17]; const float* g_final = args.in[18];
    float* out = args.out;
    float* MOD = (float*)(ws + WS_MOD); float* GC = (float*)(ws + WS_GC); bf16* Fw = (bf16*)(ws + WS_F);
    bf16* Win_t = (bf16*)(ws + WS_WIN); bf16* Wout_t = (bf16*)(ws + WS_WOUT); bf16* Wup_t = (bf16*)(ws + WS_WUP); bf16* Wdn_t = (bf16*)(ws + WS_WDN);
    bf16* XN = (bf16*)(ws + WS_XN); bf16* PROJ = (bf16*)(ws + WS_PROJ); bf16* Y = (bf16*)(ws + WS_Y); bf16* HB = (bf16*)(ws + WS_H);

    {
        LAS float* sl = (LAS float*)lds; LAS float* part = sl + 8192;
        for (int item = bx; item < NMOD / 64; item += G) {
            for (int i = tid; i < BATCH * D; i += NWAVES * 64) { const float cv = c_in[i]; sl[i] = cv / (1.0f + __expf(-cv)); }
            __syncthreads();
            const int nn = item * 64 + lane, k0 = wave * 128;
            float acc[8];
#pragma unroll
            for (int b = 0; b < 8; ++b) acc[b] = 0.f;
#pragma unroll 4
            for (int k = k0; k < k0 + 128; ++k) { const float wv = w_ada[(size_t)k * NMOD + nn];
#pragma unroll
                for (int b = 0; b < 8; ++b) acc[b] += sl[b * D + k] * wv; }
#pragma unroll
            for (int b = 0; b < 8; ++b) part[(wave * 8 + b) * 64 + lane] = acc[b];
            __syncthreads();
            float s = b_ada[nn];
#pragma unroll
            for (int w2 = 0; w2 < 8; ++w2) s += part[(w2 * 8 + wave) * 64 + lane];
            MOD[(size_t)wave * NMOD + nn] = s;
            __syncthreads();
        }
        LAS float* scr = (LAS float*)(lds + wave * 16384);
        constexpr int I_IN = (D / 64) * (DIN / 32), I_OUT = (D / 64) * (D / 32), I_UP = (D / 64) * (FF / 32), I_DN = (FF / 64) * (D / 32);
        constexpr int NITEMS = I_IN + I_OUT + I_UP + I_DN;
        for (int it = gw; it < NITEMS; it += NGW) {
            int r = it;
            if (r < I_IN) { p0_transpose_item(w_in, D, DIN, Win_t, scr, r, lane); continue; } r -= I_IN;
            if (r < I_OUT) { p0_transpose_item(w_out, D, D, Wout_t, scr, r, lane); continue; } r -= I_OUT;
            if (r < I_UP) { p0_transpose_item(w_up, D, FF, Wup_t, scr, r, lane); continue; } r -= I_UP;
            p0_transpose_item(w_down, FF, D, Wdn_t, scr, r, lane);
        }
        for (int i = bx * (NWAVES * 64) + tid; i < 32 * 8192; i += G * NWAVES * 64) {
            const int unit = i >> 13, ks = (i >> 9) & 15, ln = (i >> 3) & 63, jj = i & 7;
            const int head = unit >> 2, q = unit & 3, m = ln & 31, k = 16 * ks + 8 * (ln >> 5) + jj, tap = k >> 6, c = k & 63;
            const int mm = m & 15, cho = 16 * q + 8 * ((mm >> 2) & 1) + 4 * (mm >> 3) + (mm & 3);
            const float* Wg = (m >> 4) ? w_rg_x : w_rg_a;
            const float v = conv_w_lru[tap * LRW + 64 * head + c] * Wg[((size_t)head * 64 + c) * 64 + cho];
            Fw[i] = (bf16)f2bf(v);
        }
        for (int i = bx * (NWAVES * 64) + tid; i < 8 * 2 * 64; i += G * NWAVES * 64) {
            const int head = i >> 7, gate = (i >> 6) & 1, o = i & 63;
            const float* Wg = gate ? w_rg_x : w_rg_a; const float* bg = gate ? b_rg_x : b_rg_a;
            float s = bg[head * 64 + o];
            for (int c = 0; c < 64; ++c) s += conv_b_lru[64 * head + c] * Wg[((size_t)head * 64 + c) * 64 + o];
            GC[i] = s;
        }
    }
    grid.sync();
    norm_mod_phase(x, XN, g_mix, MOD + 1 * D, MOD + 0 * D, gw, NGW, lane);
    xcd_barrier(xbar);
    {
        pg8::Gemm g{XN, Win_t, M, DIN, D}; pg8::StaticOrder S; S.init(M, DIN, G, bx);
        pg8::EpiBf16<0> E{PROJ, DIN, nullptr, 0, 0, 1.f};
        pg8::gemm_phase<pg8::EpiBf16<0>, pg8::StaticOrder, true, true>(lds, g, S, E);
    }
    xcd_barrier(xbar);
    sc_phase(PROJ, Y, conv_w_sc, gw, NGW, lane);
    lru_phase(lds, PROJ, Y, Fw, GC, conv_w_lru, conv_b_lru, lam, G, tid, wave, lane);
    xcd_barrier(xbar);
    {
        pg8::Gemm g{Y, Wout_t, M, D, D}; pg8::StaticOrder S; S.init(M, D, G, bx);
        pg8::EpiResGate E{x, out, D, MOD + 2 * D, NMOD, SEQ / 256};
        pg8::gemm_phase<pg8::EpiResGate, pg8::StaticOrder, true, true>(lds, g, S, E);
    }
    xcd_barrier(xbar);
    norm_mod_phase(out, XN, g_mlp, MOD + 4 * D, MOD + 3 * D, gw, NGW, lane);
    xcd_barrier(xbar);
    {
        pg8::Gemm g{XN, Wup_t, M, FF, D}; pg8::StaticOrder S; S.init(M, FF, G, bx);
        pg8::EpiBf16<2> E{HB, FF, nullptr, 0, 0, 1.f};
        pg8::gemm_phase<pg8::EpiBf16<2>, pg8::StaticOrder, true, true>(lds, g, S, E);
    }
    xcd_barrier(xbar);
    {
        pg8::Gemm g{HB, Wdn_t, M, D, FF}; pg8::StaticOrder S; S.init(M, D, G, bx);
        pg8::EpiResGate E{out, out, D, MOD + 5 * D, NMOD, SEQ / 256};
        pg8::gemm_phase<pg8::EpiResGate, pg8::StaticOrder, true, true>(lds, g, S, E);
    }
    xcd_barrier(xbar);
    final_norm_phase(out, g_final, gw, NGW, lane);
}

extern "C" void kernel_launch(void* const* d_in, const int* in_sizes, int n_in, void* d_out, int out_size, void* d_ws, size_t ws_size, hipStream_t stream) {
    static int grid = 0;
    if (grid == 0) {
        if (n_in != 19 || in_sizes[0] != M * D || out_size != M * D || ws_size < WS_END) { fprintf(stderr, "kernel_launch: unexpected shapes (n_in %d, in0 %d, out %d, ws %zu); nothing launched\n", n_in, n_in > 0 ? in_sizes[0] : -1, out_size, ws_size); grid = -1; return; }
        int dev = 0, cus = 0, per_cu = 0;
        if (hipGetDevice(&dev) != hipSuccess || hipDeviceGetAttribute(&cus, hipDeviceAttributeMultiprocessorCount, dev) != hipSuccess) { grid = -1; return; }
        if (hipFuncSetAttribute((const void*)fwd_megakernel, hipFuncAttributeMaxDynamicSharedMemorySize, LDS_BYTES) != hipSuccess) { fprintf(stderr, "kernel_launch: hipFuncSetAttribute failed\n"); grid = -1; return; }
        if (hipOccupancyMaxActiveBlocksPerMultiprocessor(&per_cu, (const void*)fwd_megakernel, NWAVES * 64, LDS_BYTES) != hipSuccess || per_cu < 1) { fprintf(stderr, "kernel_launch: occupancy query gave %d\n", per_cu); per_cu = 1; }
        (void)hipGetLastError();
        grid = cus * per_cu;
    }
    if (grid < 0) return;
    if (hipMemsetAsync(d_ws, 0, 65536, stream) != hipSuccess) { fprintf(stderr, "kernel_launch: memset failed\n"); return; }
    Args a{};
    for (int i = 0; i < 19; ++i) a.in[i] = (const float*)d_in[i];
    a.out = (float*)d_out; a.ws = (unsigned char*)d_ws;
    void* kargs[] = {&a};
    hipError_t e = hipLaunchCooperativeKernel((const void*)fwd_megakernel, dim3(grid), dim3(NWAVES * 64), kargs, LDS_BYTES, stream);
    if (e != hipSuccess) fprintf(stderr, "kernel_launch: cooperative launch failed: %s (grid %d)\n", hipGetErrorString(e), grid);
}
```
